# Optimizing an MI355X kernel written in HIP

```python
import jax, jax.numpy as jnp
from jax import lax
import numpy as np

D_MODEL = 1024
BATCH = 2
SEQ = 16384
DEPTH = 1
DEC_BATCH = 32
DEC_SEQ = 16
PAST_LEN = 2048

CHUNK = 64
Q_BLOCK = 128
EPS = 1e-6
ROPE_BASE = 10000.0
MLA_HEADS = 8
MLA_NOPE = 64
MLA_ROPE = 32
MLA_QK = MLA_NOPE + MLA_ROPE
MLA_V = 64
MLA_Q_RANK = 256
MLA_KV_RANK = 128
MLA_OUT = MLA_HEADS * MLA_V
RET_HEADS = 4
RET_DK = 128
RET_DV = 128
RET_OUT = RET_HEADS * RET_DV
D_MIX = MLA_OUT + RET_OUT
O_KV = MLA_Q_RANK
O_KR = O_KV + MLA_KV_RANK
O_RQ = O_KR + MLA_ROPE
O_RK = O_RQ + RET_HEADS * RET_DK
O_RV = O_RK + RET_HEADS * RET_DK
O_RG = O_RV + RET_OUT
IN_COLS = O_RG + RET_OUT
MEM_TOKENS = 256
MEM_HEADS = 4
MEM_DH = D_MODEL // MEM_HEADS
D_FF = 2816
CONV_W = 3

kernel_name = 'hybrid_mla_retention_stream_step'


def rmsnorm(x, g):
    xf = x.astype(jnp.float32)
    y = xf * lax.rsqrt(jnp.mean(xf * xf, axis=-1, keepdims=True) + EPS)
    return (y * g.astype(jnp.float32)).astype(x.dtype)


def rope(x, pos, inv_freq):
    ang = pos.astype(jnp.float32)[:, None] * inv_freq[None, :]
    cos = jnp.cos(ang)[None, :, None, :]
    sin = jnp.sin(ang)[None, :, None, :]
    x1, x2 = jnp.split(x.astype(jnp.float32), 2, axis=-1)
    return jnp.concatenate([x1 * cos - x2 * sin, x2 * cos + x1 * sin], -1).astype(x.dtype)


def mla_freqs():
    return 1.0 / (ROPE_BASE ** (jnp.arange(0, MLA_ROPE, 2, dtype=jnp.float32) / MLA_ROPE))


def ret_freqs():
    return 1.0 / (ROPE_BASE ** jnp.linspace(0.0, 1.0, RET_DK // 2, dtype=jnp.float32))


def retention_log_decay():
    return jnp.log(1.0 - 2.0 ** (-5.0 - jnp.arange(RET_HEADS, dtype=jnp.float32)))


def mla_attend(q, pos_q, k, v, pos_k):
    s = jnp.einsum('bqhd,bkhd->bhqk', q, k).astype(jnp.float32) * (MLA_QK ** -0.5)
    allowed = (pos_k[None, :] // CHUNK) <= (pos_q[:, None] // CHUNK)
    s = jnp.where(allowed[None, None], s, -1e30)
    p = jax.nn.softmax(s, axis=-1).astype(v.dtype)
    return jnp.einsum('bhqk,bkhd->bqhd', p, v)


def retention_chunk(s_prev, q, k, v, log_g):
    L = q.shape[1]
    qf, kf, vf = q.astype(jnp.float32), k.astype(jnp.float32), v.astype(jnp.float32)
    idx = jnp.arange(L, dtype=jnp.float32)
    diff = idx[:, None] - idx[None, :]
    dmask = jnp.where(diff >= 0, jnp.exp(log_g[:, None, None] * jnp.maximum(diff, 0.0)), 0.0)
    inner = jnp.einsum('blhd,bmhd->bhlm', qf, kf) * dmask[None]
    o = jnp.einsum('bhlm,bmhe->blhe', inner, vf)
    q_dec = jnp.exp(log_g[None, :] * (idx[:, None] + 1.0))
    o = o + jnp.einsum('blhd,bhde->blhe', qf * q_dec[None, :, :, None], s_prev)
    k_dec = jnp.exp(log_g[None, :] * (L - 1.0 - idx)[:, None])
    s_new = jnp.exp(log_g * L)[None, :, None, None] * s_prev + jnp.einsum('blhd,blhe->bhde', kf * k_dec[None, :, :, None], vf)
    return s_new, o


def head_layernorm(o, g):
    mu = jnp.mean(o, axis=-1, keepdims=True)
    var = jnp.mean(jnp.square(o - mu), axis=-1, keepdims=True)
    y = (o - mu) * lax.rsqrt(var + EPS)
    return y.reshape(o.shape[0], o.shape[1], -1) * g.astype(jnp.float32)


def mem_kv(mem, mem_norm_g, w_ck, w_cv):
    m = rmsnorm(mem, mem_norm_g)
    return jnp.einsum('bmd,dhe->bmhe', m, w_ck), jnp.einsum('bmd,dhe->bmhe', m, w_cv)


def mem_attend(h, mk, mv, w_cq, w_co):
    b, t, _ = h.shape
    q = jnp.einsum('btd,dhe->bthe', h, w_cq)
    s = jnp.einsum('bthe,bmhe->bhtm', q, mk).astype(jnp.float32) * (MEM_DH ** -0.5)
    p = jax.nn.softmax(s, axis=-1).astype(mv.dtype)
    o = jnp.einsum('bhtm,bmhe->bthe', p, mv).reshape(b, t, MEM_HEADS * MEM_DH)
    return jnp.einsum('btc,cd->btd', o, w_co)


def conv_ffn(h, buf, w_up, conv_w, conv_b, w_down):
    t = h.shape[1]
    u = jnp.einsum('btd,df->btf', h, w_up)
    ext = jnp.concatenate([buf.astype(u.dtype), u], axis=1)
    c = conv_b + conv_w[0] * ext[:, 0:t]
    for j in range(1, CONV_W):
        c = c + conv_w[j] * ext[:, j:j + t]
    a, g = jnp.split(c, 2, axis=-1)
    y = jnp.einsum('btf,fd->btd', jax.nn.silu(a) * g, w_down)
    return y, ext[:, -(CONV_W - 1):]


def trunk_layer(x, pos, past_ckv, past_kr, ret_s0, mk, mv, conv_buf, w, is_prompt):
    b, t, _ = x.shape
    dt = x.dtype
    h = rmsnorm(x, w['norm_mix_g'])
    z = jnp.einsum('btd,dc->btc', h, w['w_in'])
    mf = mla_freqs()
    cq = rmsnorm(z[..., :O_KV], w['q_norm_g'])
    q = jnp.einsum('btr,rhd->bthd', cq, w['w_uq'])
    q = jnp.concatenate([q[..., :MLA_NOPE], rope(q[..., MLA_NOPE:], pos, mf)], -1)
    ckv = rmsnorm(z[..., O_KV:O_KR], w['kv_norm_g'])
    kr = rope(z[..., O_KR:O_RQ][:, :, None, :], pos, mf)[:, :, 0, :]
    if past_ckv is None:
        ckv_all, kr_all, pos_k = ckv, kr, pos
    else:
        ckv_all = jnp.concatenate([past_ckv.astype(dt), ckv], axis=1)
        kr_all = jnp.concatenate([past_kr.astype(dt), kr], axis=1)
        pos_k = jnp.arange(ckv_all.shape[1], dtype=jnp.int32)
    k_nope = jnp.einsum('bnr,rhd->bnhd', ckv_all, w['w_uk'])
    k = jnp.concatenate([k_nope, jnp.broadcast_to(kr_all[:, :, None, :], k_nope.shape[:3] + (MLA_ROPE,))], -1)
    v = jnp.einsum('bnr,rhd->bnhd', ckv_all, w['w_uv'])
    if is_prompt:
        nb = t // Q_BLOCK
        qb = q.reshape(b, nb, Q_BLOCK, MLA_HEADS, MLA_QK).transpose(1, 0, 2, 3, 4)
        pb = pos.reshape(nb, Q_BLOCK)
        ob = lax.map(lambda a: mla_attend(a[0], a[1], k, v, pos_k), (qb, pb))
        o_mla = ob.transpose(1, 0, 2, 3, 4).reshape(b, t, MLA_OUT)
    else:
        o_mla = mla_attend(q, pos, k, v, pos_k).reshape(b, t, MLA_OUT)
    rf = ret_freqs()
    rq = rope(z[..., O_RQ:O_RK].reshape(b, t, RET_HEADS, RET_DK), pos, rf)
    rk = rope(z[..., O_RK:O_RV].reshape(b, t, RET_HEADS, RET_DK), pos, rf) * (RET_DK ** -0.5)
    rv = z[..., O_RV:O_RG].reshape(b, t, RET_HEADS, RET_DV)
    log_g = retention_log_decay()
    s0 = ret_s0.astype(jnp.float32)
    if is_prompt:
        nc = t // CHUNK
        to_chunks = lambda a: a.reshape(b, nc, CHUNK, a.shape[2], a.shape[3]).transpose(1, 0, 2, 3, 4)
        s_fin, oc = lax.scan(lambda s, xs: retention_chunk(s, xs[0], xs[1], xs[2], log_g), s0,
                             (to_chunks(rq), to_chunks(rk), to_chunks(rv)))
        o_ret = oc.transpose(1, 0, 2, 3, 4).reshape(b, t, RET_HEADS, RET_DV)
    else:
        s_fin, o_ret = retention_chunk(s0, rq, rk, rv, log_g)
    o_ret = head_layernorm(o_ret, w['ret_gn_g']) * jax.nn.silu(z[..., O_RG:].astype(jnp.float32))
    mixed = jnp.concatenate([o_mla, o_ret.astype(dt)], axis=-1)
    x = x + jnp.einsum('btc,cd->btd', mixed, w['w_o'])
    x = x + mem_attend(rmsnorm(x, w['norm_mem_g']), mk, mv, w['w_cq'], w['w_co'])
    y, new_buf = conv_ffn(rmsnorm(x, w['norm_ffn_g']), conv_buf, w['w_up'], w['conv_w'], w['conv_b'], w['w_down'])
    x = x + y
    return x, ckv, kr, s_fin.astype(dt), new_buf


def setup_inputs(seed: int = 0) -> dict:
    key = jax.random.key(seed)
    ks = jax.random.split(key, 40)
    ctr = iter(range(40))
    f32 = jnp.float32
    L = DEPTH

    def nrm(shape, scale):
        return jax.random.normal(ks[next(ctr)], shape, f32) * scale

    def gain(shape):
        return 1.0 + nrm(shape, 0.02)

    return {
        'x_prompt': nrm((BATCH, SEQ, D_MODEL), 1.0),
        'x_sample': nrm((DEC_BATCH, DEC_SEQ, D_MODEL), 1.0),
        'cache_mla_ckv': nrm((L, DEC_BATCH, PAST_LEN, MLA_KV_RANK), 1.0),
        'cache_mla_krope': nrm((L, DEC_BATCH, PAST_LEN, MLA_ROPE), 1.0),
        'state_ret': nrm((L, DEC_BATCH, RET_HEADS, RET_DK, RET_DV), 0.3),
        'state_ffn_conv': nrm((L, DEC_BATCH, CONV_W - 1, 2 * D_FF), 1.0),
        'cache_mem_k': nrm((L, DEC_BATCH, MEM_TOKENS, MEM_HEADS, MEM_DH), 1.0),
        'cache_mem_v': nrm((L, DEC_BATCH, MEM_TOKENS, MEM_HEADS, MEM_DH), 1.0),
        'mem_prompt': nrm((BATCH, MEM_TOKENS, D_MODEL), 1.0),
        'norm_mix_g': gain((L, D_MODEL)),
        'w_in': nrm((L, D_MODEL, IN_COLS), D_MODEL ** -0.5),
        'q_norm_g': gain((L, MLA_Q_RANK)),
        'kv_norm_g': gain((L, MLA_KV_RANK)),
        'w_uq': nrm((L, MLA_Q_RANK, MLA_HEADS, MLA_QK), MLA_Q_RANK ** -0.5),
        'w_uk': nrm((L, MLA_KV_RANK, MLA_HEADS, MLA_NOPE), MLA_KV_RANK ** -0.5),
        'w_uv': nrm((L, MLA_KV_RANK, MLA_HEADS, MLA_V), MLA_KV_RANK ** -0.5),
        'ret_gn_g': gain((L, RET_OUT)),
        'w_o': nrm((L, D_MIX, D_MODEL), D_MIX ** -0.5),
        'norm_mem_g': gain((L, D_MODEL)),
        'mem_norm_g': gain((L, D_MODEL)),
        'w_cq': nrm((L, D_MODEL, MEM_HEADS, MEM_DH), D_MODEL ** -0.5),
        'w_ck': nrm((L, D_MODEL, MEM_HEADS, MEM_DH), D_MODEL ** -0.5),
        'w_cv': nrm((L, D_MODEL, MEM_HEADS, MEM_DH), D_MODEL ** -0.5),
        'w_co': nrm((L, MEM_HEADS * MEM_DH, D_MODEL), (MEM_HEADS * MEM_DH) ** -0.5),
        'norm_ffn_g': gain((L, D_MODEL)),
        'w_up': nrm((L, D_MODEL, 2 * D_FF), D_MODEL ** -0.5),
        'conv_w': nrm((L, CONV_W, 2 * D_FF), CONV_W ** -0.5),
        'conv_b': nrm((L, 2 * D_FF), 0.02),
        'w_down': nrm((L, D_FF, D_MODEL), D_FF ** -0.5),
        'final_norm_g': gain((D_MODEL,)),
    }


def reference(x_prompt, x_sample, cache_mla_ckv, cache_mla_krope, state_ret, state_ffn_conv,
              cache_mem_k, cache_mem_v, mem_prompt, norm_mix_g, w_in, q_norm_g, kv_norm_g,
              w_uq, w_uk, w_uv, ret_gn_g, w_o, norm_mem_g, mem_norm_g, w_cq, w_ck, w_cv, w_co,
              norm_ffn_g, w_up, conv_w, conv_b, w_down, final_norm_g):
    bp, tp, _ = x_prompt.shape
    ts = x_sample.shape[1]
    past = cache_mla_ckv.shape[2]
    pos_p = jnp.arange(tp, dtype=jnp.int32)
    pos_s = past + jnp.arange(ts, dtype=jnp.int32)
    hp, hs = x_prompt, x_sample
    p_ckv, p_kr, p_ret, p_conv, p_mk, p_mv = [], [], [], [], [], []
    s_ckv, s_kr, s_ret, s_conv = [], [], [], []
    for l in range(DEPTH):
        w = {'norm_mix_g': norm_mix_g[l], 'w_in': w_in[l], 'q_norm_g': q_norm_g[l],
             'kv_norm_g': kv_norm_g[l], 'w_uq': w_uq[l], 'w_uk': w_uk[l], 'w_uv': w_uv[l],
             'ret_gn_g': ret_gn_g[l], 'w_o': w_o[l], 'norm_mem_g': norm_mem_g[l],
             'w_cq': w_cq[l], 'w_co': w_co[l], 'norm_ffn_g': norm_ffn_g[l], 'w_up': w_up[l],
             'conv_w': conv_w[l], 'conv_b': conv_b[l], 'w_down': w_down[l]}
        mk_p, mv_p = mem_kv(mem_prompt, mem_norm_g[l], w_ck[l], w_cv[l])
        s0_p = jnp.zeros((bp, RET_HEADS, RET_DK, RET_DV), jnp.float32)
        buf0_p = jnp.zeros((bp, CONV_W - 1, 2 * D_FF), x_prompt.dtype)
        hp, ckv1, kr1, ret1, conv1 = trunk_layer(hp, pos_p, None, None, s0_p, mk_p, mv_p, buf0_p, w, True)
        hs, ckv2, kr2, ret2, conv2 = trunk_layer(hs, pos_s, cache_mla_ckv[l], cache_mla_krope[l], state_ret[l],
                                                 cache_mem_k[l], cache_mem_v[l], state_ffn_conv[l], w, False)
        p_ckv.append(ckv1); p_kr.append(kr1); p_ret.append(ret1); p_conv.append(conv1)
        p_mk.append(mk_p); p_mv.append(mv_p)
        s_ckv.append(ckv2); s_kr.append(kr2); s_ret.append(ret2); s_conv.append(conv2)
    y_prompt = rmsnorm(hp, final_norm_g)
    y_sample = rmsnorm(hs, final_norm_g)
    return (y_prompt, y_sample,
            jnp.stack(p_ckv), jnp.stack(p_kr), jnp.stack(p_ret), jnp.stack(p_conv),
            jnp.stack(p_mk), jnp.stack(p_mv),
            jnp.stack(s_ckv), jnp.stack(s_kr), jnp.stack(s_ret), jnp.stack(s_conv))
```

```cpp
#include <hip/hip_runtime.h>
#include <hip/hip_cooperative_groups.h>
#include <cstdio>
#include <cstdint>
namespace cg = cooperative_groups;

#define LAS __attribute__((address_space(3)))
typedef unsigned short bf16;
typedef short bf16x8 __attribute__((ext_vector_type(8)));
typedef float f32x2 __attribute__((ext_vector_type(2)));
typedef float f32x4 __attribute__((ext_vector_type(4)));
typedef float f32x16 __attribute__((ext_vector_type(16)));
typedef unsigned u32x2 __attribute__((ext_vector_type(2)));
typedef unsigned u32x4 __attribute__((ext_vector_type(4)));

constexpr int MP = 32768, MS = 512, MT = MP + MS, DM = 1024, SEQ = 16384, PAST = 2048;
constexpr int NZ = 2560;
constexpr int ZC_CKV = 256, ZC_KR = 384, ZC_RQ = 416, ZC_RK = 928, ZC_RV = 1440, ZC_RG = 1952, ZC_END = 2464;
constexpr int NFF = 2816, NUP = 5632;
constexpr float EPS = 1e-6f;
constexpr float LG2_10000 = 13.287712379549449f;
constexpr float LOG2E = 1.4426950408889634f;
constexpr size_t O_Y = 0;
constexpr size_t O_PCKV = (size_t)MT * DM;
constexpr size_t O_PKR = O_PCKV + (size_t)MP * 128;
constexpr size_t O_PRET = O_PKR + (size_t)MP * 32;
constexpr size_t O_PCONV = O_PRET + 2 * 4 * 128 * 128;
constexpr size_t O_PMK = O_PCONV + 2 * 2 * NUP;
constexpr size_t O_PMV = O_PMK + 2 * 256 * 1024;
constexpr size_t O_SCKV = O_PMV + 2 * 256 * 1024;
constexpr size_t O_SKR = O_SCKV + (size_t)MS * 128;
constexpr size_t O_SRET = O_SKR + (size_t)MS * 32;
constexpr size_t O_SCONV = O_SRET + 32 * 4 * 128 * 128;
constexpr size_t O_END = O_SCONV + 32 * 2 * NUP;
static_assert(O_END == 43063296, "output size");

__device__ __forceinline__ float bf2f(unsigned b) { return __uint_as_float(b << 16); }
__device__ __forceinline__ float bflo(unsigned w) { return __uint_as_float(w << 16); }
__device__ __forceinline__ float bfhi(unsigned w) { return __uint_as_float(w & 0xffff0000u); }
typedef __bf16 bf16x2_t __attribute__((ext_vector_type(2)));
__device__ __forceinline__ unsigned pk2(float lo, float hi) { const f32x2 v = {lo, hi}; return __builtin_bit_cast(unsigned, __builtin_convertvector(v, bf16x2_t)); }
__device__ __forceinline__ bf16 f2bf(float f) { return (bf16)(pk2(f, 0.f) & 0xffffu); }
template <int K> __device__ __forceinline__ float swz_xor(float v) { return __int_as_float(__builtin_amdgcn_ds_swizzle(__float_as_int(v), (K << 10) | 0x1f)); }
__device__ __forceinline__ float half_sum(float v) { auto rr = __builtin_amdgcn_permlane32_swap(__float_as_uint(v), __float_as_uint(v), false, false); return __uint_as_float(rr[0]) + __uint_as_float(rr[1]); }
__device__ __forceinline__ float half_max(float v) { auto rr = __builtin_amdgcn_permlane32_swap(__float_as_uint(v), __float_as_uint(v), false, false); return fmaxf(__uint_as_float(rr[0]), __uint_as_float(rr[1])); }
__device__ __forceinline__ float wave_sum(float v) { v += swz_xor<1>(v); v += swz_xor<2>(v); v += swz_xor<4>(v); v += swz_xor<8>(v); v += swz_xor<16>(v); return half_sum(v); }
__device__ __forceinline__ float wave_max(float v) { v = fmaxf(v, swz_xor<1>(v)); v = fmaxf(v, swz_xor<2>(v)); v = fmaxf(v, swz_xor<4>(v)); v = fmaxf(v, swz_xor<8>(v)); v = fmaxf(v, swz_xor<16>(v)); return half_max(v); }
__device__ __forceinline__ int crow(int r, int hi) { return (r & 3) + 8 * (r >> 2) + 4 * hi; }
__device__ __forceinline__ int row_pos(int r) { return r < MP ? (r & (SEQ - 1)) : PAST + ((r - MP) & 15); }
__device__ __forceinline__ void sincos_rev(float ang, float& s, float& c) {
    float rev = ang * 0.15915494309189535f; rev = rev - floorf(rev);
    s = __builtin_amdgcn_sinf(rev); c = __builtin_amdgcn_cosf(rev);
}
__device__ __forceinline__ float ex2f(float x) { return __builtin_amdgcn_exp2f(x); }
__device__ __forceinline__ float silu(float x) { return x * __builtin_amdgcn_rcpf(1.f + __builtin_amdgcn_exp2f(-1.4426950408889634f * x)); }

constexpr int TAB_OFF = 153600;
__device__ __forceinline__ int my_tid(LAS unsigned char* lds) {
    const unsigned hw = (unsigned)__builtin_amdgcn_s_getreg((5 << 11) | 4) & 63u;
    const int wv = __builtin_amdgcn_readfirstlane(*(volatile LAS int*)(lds + TAB_OFF + 512 + 4 * hw));
    int ln; asm volatile("v_mbcnt_lo_u32_b32 %0, -1, 0\n\tv_mbcnt_hi_u32_b32 %0, -1, %0" : "=v"(ln));
    return wv * 64 + ln;
}
__device__ __forceinline__ unsigned long long tab_get(LAS unsigned char* lds, int i) {
    const unsigned long long v = ((const volatile LAS unsigned long long*)(lds + TAB_OFF))[i];
    const unsigned lo = __builtin_amdgcn_readfirstlane((unsigned)v), hi = __builtin_amdgcn_readfirstlane((unsigned)(v >> 32));
    return ((unsigned long long)hi << 32) | lo;
}
#define INP(i) ((const float*)tab_get(lds, (i)))
#define OUTP() ((float*)tab_get(lds, 30))
#define WSB(off) ((bf16*)((unsigned char*)tab_get(lds, 31) + (off)))
#define WSF(off) ((float*)((unsigned char*)tab_get(lds, 31) + (off)))
#define MFMA32(a, b, c) __builtin_amdgcn_mfma_f32_32x32x16_bf16((a), (b), (c), 0, 0, 0)

namespace pg8 {
#define PG8_LAS __attribute__((address_space(3)))
typedef unsigned short bf16_t;
constexpr int BM = 256, BK = 64, HALF = 128, HTB = HALF * BK * 2, STAGE_BYTES = 8 * HTB, NXCD = 8, WGM = 8;
__host__ __device__ __forceinline__ int lds_byte(int r, int c) { const int st = (r >> 4) * 2 + (c >> 5), rr = r & 15, cc = c & 31, ob = rr * 64 + cc * 2; return st * 1024 + (ob ^ (((ob >> 9) & 1) << 5)); }
__host__ __device__ __forceinline__ void stage_rc(int b, int& R, int& C) { const int st = b / 1024, sb = b % 1024, swz = sb ^ (((sb >> 9) & 1) << 5); R = (st >> 1) * 16 + swz / 64; C = (st & 1) * 32 + (swz % 64) / 2; }
__host__ __device__ __forceinline__ int perm32(int rho) { const int n = rho >> 4, i = rho & 15; return 8 * (i >> 2) + 4 * n + (i & 3); }

struct Unit { int pm, pn; };
struct Gemm { const bf16_t* A; const bf16_t* Bt; int M, N, K, lda, ldb; };

struct StaticOrder {
    int nM, nN, nwg, G, c;
    __host__ __device__ void init(int M, int N, int G_, int c_) { nM = M / BM; nN = N / BM; nwg = nM * nN; G = G_; c = c_; }
    __host__ __device__ bool next(int i, Unit& u) const {
        const long L = (long)i * G + c; if (L >= nwg) return false;
        int wgid = (int)L; { const int q = nwg / NXCD, r = nwg % NXCD, xcd = wgid % NXCD, off = wgid / NXCD; wgid = (xcd < r ? xcd * (q + 1) : r * (q + 1) + (xcd - r) * q) + off; }
        const int nig = WGM * nN, gid = wgid / nig, fm = gid * WGM, gsz = (nM - fm) < WGM ? (nM - fm) : WGM;
        u.pm = fm + ((wgid % nig) % gsz); u.pn = (wgid % nig) / gsz; return true;
    }
};

template <class Epi, class Sched, bool ALIGN_EPI = true, bool SP2 = true>
__device__ __forceinline__ void gemm_phase(PG8_LAS unsigned char* lds, const Gemm g, const Sched& S, const Epi& E) {
    const int tid_ = my_tid(lds);
    const int tid = tid_, wid = __builtin_amdgcn_readfirstlane(tid >> 6), lane = tid & 63, wr = wid >> 2, wc = wid & 3, fr = lane & 15, fq = lane >> 4;
    const int K = g.K, nt = K / BK;
    unsigned voffA[2], voffB[2];
#pragma unroll
    for (int i = 0; i < 2; ++i) { int R, C; stage_rc(tid * 16 + i * 8192, R, C); const int Rb = ((R & ~31) + perm32(R & 31));
        voffA[i] = (unsigned)(R * g.lda + C) * 2u; voffB[i] = (unsigned)(Rb * g.ldb + C) * 2u; }
    const size_t kstep = (size_t)(BK * 2);
    const size_t hstepA = (size_t)HALF * g.lda * 2, hstepB = (size_t)HALF * g.ldb * 2;
    const size_t tstepA = 2 * hstepA, tstepB = 2 * hstepB;
    const unsigned ldsw = (unsigned)wid * 1024u;
    const int aoff = lds_byte(wr * 64 + fr, fq * 8), boff = lds_byte(wc * 32 + fr, fq * 8);
#define PG8_SA(b, h) (((b) * 2 + (h)) * HTB)
#define PG8_SB(b, h) ((4 + (b) * 2 + (h)) * HTB)
#define PG8_STAGE(bufoff, gbase, voff) do { _Pragma("unroll") for (int _i = 0; _i < 2; ++_i) \
        __builtin_amdgcn_global_load_lds((const unsigned*)((const char*)(gbase) + (voff)[_i]), (PG8_LAS unsigned*)(lds + (bufoff) + ldsw + _i * 8192), 16, 0, 0); } while (0)
#define PG8_LDA(dst, b, h) do { _Pragma("unroll") for (int m = 0; m < 4; ++m) _Pragma("unroll") for (int k = 0; k < 2; ++k) dst[m][k] = *(const PG8_LAS bf16x8*)(lds + PG8_SA(b, h) + aoff + m * 2048 + k * 1024); } while (0)
#define PG8_LDB(dst, b, h) do { _Pragma("unroll") for (int n = 0; n < 2; ++n) _Pragma("unroll") for (int k = 0; k < 2; ++k) dst[n][k] = *(const PG8_LAS bf16x8*)(lds + PG8_SB(b, h) + boff + n * 2048 + k * 1024); } while (0)
#define PG8_MMA(ai, bj, At, Bt) do { __builtin_amdgcn_s_setprio(1); _Pragma("unroll") for (int m = 0; m < 4; ++m) _Pragma("unroll") for (int n = 0; n < 2; ++n) _Pragma("unroll") for (int k = 0; k < 2; ++k) \
        acc[ai][bj][m][n] = __builtin_amdgcn_mfma_f32_16x16x32_bf16(Bt[n][k], At[m][k], acc[ai][bj][m][n], 0, 0, 0); __builtin_amdgcn_s_setprio(0); } while (0)
#define PG8_WAIT_V(n) asm volatile("s_waitcnt vmcnt(" #n ")" ::: "memory")
#define PG8_WAIT_L(n) asm volatile("s_waitcnt lgkmcnt(" #n ")" ::: "memory")
#define PG8_BAR __builtin_amdgcn_s_barrier()
#define PG8_SCHED __builtin_amdgcn_sched_barrier(0)
    Unit cur, nxt; int ui = 0;
    if (!S.next(0, cur)) return;
    f32x4 acc[2][2][4][2];
#pragma unroll
    for (int a = 0; a < 2; ++a)
#pragma unroll
        for (int b = 0; b < 2; ++b)
#pragma unroll
            for (int m = 0; m < 4; ++m)
#pragma unroll
                for (int n = 0; n < 2; ++n) acc[a][b][m][n] = (f32x4){0.f, 0.f, 0.f, 0.f};
    bf16x8 At[4][2], B0[2][2], B1[2][2];
    const char* cA = (const char*)g.A + (size_t)cur.pm * tstepA; const char* cB = (const char*)g.Bt + (size_t)cur.pn * tstepB;
    static_assert(SP2, "only the SP2 loop is carried here");
    PG8_STAGE(PG8_SB(0, 0), cB, voffB); PG8_STAGE(PG8_SB(0, 1), cB + hstepB, voffB); PG8_STAGE(PG8_SA(0, 0), cA, voffA); PG8_STAGE(PG8_SA(0, 1), cA + hstepA, voffA);
    if (wr == 1) PG8_BAR;
    PG8_WAIT_V(2); PG8_BAR;
    PG8_STAGE(PG8_SB(1, 0), cB + kstep, voffB); PG8_STAGE(PG8_SA(1, 0), cA + kstep, voffA); PG8_STAGE(PG8_SB(1, 1), cB + hstepB + kstep, voffB);
    PG8_WAIT_V(6); PG8_BAR;
    for (;;) {
        const bool has_next = S.next(ui + 1, nxt);
        const char* nA = has_next ? (const char*)g.A + (size_t)nxt.pm * tstepA : cA; const char* nB = has_next ? (const char*)g.Bt + (size_t)nxt.pn * tstepB : cB;
        for (int t = 0; t < nt; t += 2) {
            const bool last = (t == nt - 2);
            const char* a1 = cA + (size_t)(t + 1) * kstep;
            const char* a2 = last ? nA : cA + (size_t)(t + 2) * kstep; const char* b2 = last ? nB : cB + (size_t)(t + 2) * kstep;
            const char* a3 = a2 + kstep; const char* b3 = b2 + kstep;
            PG8_LDB(B0, 0, 0); PG8_LDB(B1, 0, 1); PG8_SCHED; PG8_LDA(At, 0, 0); PG8_STAGE(PG8_SA(1, 1), a1 + hstepA, voffA);
            PG8_WAIT_V(8); PG8_WAIT_L(0); PG8_BAR; PG8_MMA(0, 0, At, B0); PG8_MMA(0, 1, At, B1); PG8_BAR; PG8_SCHED;
            PG8_LDA(At, 0, 1); PG8_STAGE(PG8_SB(0, 0), b2, voffB); PG8_STAGE(PG8_SB(0, 1), b2 + hstepB, voffB); PG8_STAGE(PG8_SA(0, 0), a2, voffA);
            PG8_WAIT_V(8); PG8_WAIT_L(0); PG8_BAR; PG8_MMA(1, 0, At, B0); PG8_MMA(1, 1, At, B1); PG8_BAR; PG8_SCHED;
            PG8_LDB(B0, 1, 0); PG8_LDB(B1, 1, 1); PG8_SCHED; PG8_LDA(At, 1, 0); PG8_STAGE(PG8_SA(0, 1), a2 + hstepA, voffA);
            PG8_WAIT_V(8); PG8_WAIT_L(0); PG8_BAR; PG8_MMA(0, 0, At, B0); PG8_MMA(0, 1, At, B1); PG8_BAR; PG8_SCHED;
            PG8_LDA(At, 1, 1); PG8_STAGE(PG8_SB(1, 0), b3, voffB); PG8_STAGE(PG8_SB(1, 1), b3 + hstepB, voffB); PG8_STAGE(PG8_SA(1, 0), a3, voffA);
            PG8_WAIT_V(8); PG8_WAIT_L(0); PG8_BAR; PG8_MMA(1, 0, At, B0); PG8_MMA(1, 1, At, B1); PG8_BAR; PG8_SCHED;
        }
        if constexpr (ALIGN_EPI) { if (wr == 0) PG8_BAR; }
        E(acc, cur, wr, wc, fr, fq);
        if (!has_next) break;
#pragma unroll
        for (int a = 0; a < 2; ++a)
#pragma unroll
            for (int b = 0; b < 2; ++b)
#pragma unroll
                for (int m = 0; m < 4; ++m)
#pragma unroll
                    for (int n = 0; n < 2; ++n) acc[a][b][m][n] = (f32x4){0.f, 0.f, 0.f, 0.f};
        cur = nxt; cA = nA; cB = nB; ++ui;
        if constexpr (ALIGN_EPI) { if (wr == 1) PG8_BAR; }
    }
    PG8_WAIT_V(0);
    if constexpr (!ALIGN_EPI) { if (wr == 0) PG8_BAR; }
    PG8_BAR;
#undef PG8_SA
#undef PG8_SB
#undef PG8_STAGE
#undef PG8_LDA
#undef PG8_LDB
#undef PG8_MMA
#undef PG8_WAIT_V
#undef PG8_WAIT_L
#undef PG8_BAR
#undef PG8_SCHED
}
}
namespace pg8 {
#define EPI_ARGS f32x4 (&acc)[2][2][4][2], const Unit& u, int wr, int wc, int fr, int fq
struct EpiStoreBf16 {
    bf16* O; int ldc;
    __device__ __forceinline__ void operator()(EPI_ARGS) const {
        const int row0 = u.pm * BM + wr * 64 + fr, col0 = u.pn * BM + wc * 32 + 8 * fq;
#pragma unroll
        for (int ai = 0; ai < 2; ++ai)
#pragma unroll
            for (int m = 0; m < 4; ++m) { bf16* rowp = O + (size_t)(row0 + ai * HALF + m * 16) * ldc + col0;
#pragma unroll
                for (int bj = 0; bj < 2; ++bj) { const f32x4 v0 = acc[ai][bj][m][0], v1 = acc[ai][bj][m][1];
                    u32x4 w; w.x = pk2(v0[0], v0[1]); w.y = pk2(v0[2], v0[3]); w.z = pk2(v1[0], v1[1]); w.w = pk2(v1[2], v1[3]);
                    *(u32x4*)(rowp + bj * HALF) = w; } }
    }
};
struct EpiMemKV {
    float* out; bf16* MK;
    __device__ __forceinline__ void operator()(EPI_ARGS) const {
        const int row0 = u.pm * BM + wr * 64 + fr;
#pragma unroll
        for (int ai = 0; ai < 2; ++ai)
#pragma unroll
            for (int m = 0; m < 4; ++m) { const int row = row0 + ai * HALF + m * 16;
#pragma unroll
                for (int bj = 0; bj < 2; ++bj) { const int col = u.pn * BM + bj * HALF + wc * 32 + 8 * fq; const f32x4 v0 = acc[ai][bj][m][0], v1 = acc[ai][bj][m][1];
                    if (col < 1024) { float* o = out + O_PMK + (size_t)row * 1024 + col; *(f32x4*)o = v0; *(f32x4*)(o + 4) = v1;
                        u32x4 w; w.x = pk2(v0[0], v0[1]); w.y = pk2(v0[2], v0[3]); w.z = pk2(v1[0], v1[1]); w.w = pk2(v1[2], v1[3]);
                        *(u32x4*)(MK + (size_t)row * 1024 + col) = w;
                    } else { float* o = out + O_PMV + (size_t)row * 1024 + (col - 1024); *(f32x4*)o = v0; *(f32x4*)(o + 4) = v1; } } }
    }
};
struct EpiResid {
    const float* base; float* X;
    __device__ __forceinline__ void operator()(EPI_ARGS) const {
        const int row0 = u.pm * BM + wr * 64 + fr, col0 = u.pn * BM + wc * 32 + 8 * fq;
#pragma unroll
        for (int ai = 0; ai < 2; ++ai)
#pragma unroll
            for (int m = 0; m < 4; ++m) { const int row = row0 + ai * HALF + m * 16;
                const float* b = base + (size_t)row * DM + col0; float* o = X + (size_t)row * DM + col0;
#pragma unroll
                for (int bj = 0; bj < 2; ++bj) { const f32x4 b0 = *(const f32x4*)(b + bj * HALF), b1 = *(const f32x4*)(b + bj * HALF + 4);
                    *(f32x4*)(o + bj * HALF) = b0 + acc[ai][bj][m][0]; *(f32x4*)(o + bj * HALF + 4) = b1 + acc[ai][bj][m][1]; } }
    }
};
struct EpiAtomicAdd {
    float* X;
    __device__ __forceinline__ void operator()(EPI_ARGS) const {
        const int row0 = u.pm * BM + wr * 64 + fr, col0 = u.pn * BM + wc * 32 + 8 * fq;
#pragma unroll
        for (int ai = 0; ai < 2; ++ai)
#pragma unroll
            for (int m = 0; m < 4; ++m) { float* o = X + (size_t)(row0 + ai * HALF + m * 16) * DM + col0;
#pragma unroll
                for (int bj = 0; bj < 2; ++bj)
#pragma unroll
                    for (int n = 0; n < 2; ++n)
#pragma unroll
                        for (int e = 0; e < 4; ++e) (void)__hip_atomic_fetch_add(o + bj * HALF + 4 * n + e, acc[ai][bj][m][n][e], __ATOMIC_RELAXED, __HIP_MEMORY_SCOPE_AGENT); }
    }
};
struct EpiUp {
    bf16* U; int grow0; float* out;
    __device__ __forceinline__ void operator()(EPI_ARGS) const {
        const int row0 = u.pm * BM + wr * 64 + fr, col0 = u.pn * BM + wc * 32 + 8 * fq, f0 = u.pn * 128 + wc * 32 + 8 * fq;
#pragma unroll
        for (int ai = 0; ai < 2; ++ai)
#pragma unroll
            for (int m = 0; m < 4; ++m) { const int lrow = row0 + ai * HALF + m * 16, R = grow0 + lrow; bf16* rowp = U + (size_t)lrow * NUP + col0;
                float* co = nullptr;
                if (R < MP) { const int t = R & (SEQ - 1); if (t >= SEQ - 2) co = out + O_PCONV + (size_t)((R >> 14) * 2 + (t - (SEQ - 2))) * NUP + f0; }
                else { const int q = R - MP, t = q & 15; if (t >= 14) co = out + O_SCONV + (size_t)((q >> 4) * 2 + (t - 14)) * NUP + f0; }
#pragma unroll
                for (int bj = 0; bj < 2; ++bj) { const f32x4 v0 = acc[ai][bj][m][0], v1 = acc[ai][bj][m][1];
                    u32x4 w; w.x = pk2(v0[0], v0[1]); w.y = pk2(v0[2], v0[3]); w.z = pk2(v1[0], v1[1]); w.w = pk2(v1[2], v1[3]);
                    *(u32x4*)(rowp + bj * HALF) = w;
                    if (co) { *(f32x4*)(co + bj * NFF) = v0; *(f32x4*)(co + bj * NFF + 4) = v1; } } }
    }
};
__device__ __forceinline__ float dpp_prev(float cur, float prevblk, int which) {
    const int c = __float_as_int(cur), p = __float_as_int(prevblk);
    if (which == 1) { const int t = __builtin_amdgcn_mov_dpp(p, 0x121, 0xf, 0xf, true); return __int_as_float(__builtin_amdgcn_update_dpp(t, c, 0x111, 0xf, 0xf, false)); }
    const int t = __builtin_amdgcn_mov_dpp(p, 0x122, 0xf, 0xf, true); return __int_as_float(__builtin_amdgcn_update_dpp(t, c, 0x112, 0xf, 0xf, false));
}
struct EpiUpConv {
    bf16* ACT; bf16* HB; float* out; const float* cw; const float* cb; LAS unsigned char* lds;
    __device__ __forceinline__ void operator()(f32x4 (&acc)[2][2][4][2], const Unit& u, int, int, int, int) const {
        const int tid = my_tid(lds), wid = __builtin_amdgcn_readfirstlane(tid >> 6), lane = tid & 63, wr = wid >> 2, wc = wid & 3, fr = lane & 15, fq = lane >> 4;
        const int f0 = u.pn * 128 + wc * 32 + 8 * fq, rowt = u.pm * BM + wr * 64 + fr;
#pragma unroll
        for (int ai = 0; ai < 2; ++ai) { const int gidx = u.pm * 4 + ai * 2 + wr;
            if (fr < 2) { bf16* h = HB + (size_t)(gidx * 4 + fr) * NUP + f0;
#pragma unroll
                for (int bj = 0; bj < 2; ++bj) { const f32x4 v0 = acc[ai][bj][0][0], v1 = acc[ai][bj][0][1]; u32x4 w; w.x = pk2(v0[0], v0[1]); w.y = pk2(v0[2], v0[3]); w.z = pk2(v1[0], v1[1]); w.w = pk2(v1[2], v1[3]); *(u32x4*)(h + bj * NFF) = w; } }
            if (fr >= 14) { bf16* h = HB + (size_t)(gidx * 4 + 2 + (fr - 14)) * NUP + f0; const int R = rowt + ai * HALF + 48, t = R & (SEQ - 1);
                float* co = (t >= SEQ - 2) ? out + O_PCONV + (size_t)((R >> 14) * 2 + (t - (SEQ - 2))) * NUP + f0 : nullptr;
#pragma unroll
                for (int bj = 0; bj < 2; ++bj) { const f32x4 v0 = acc[ai][bj][3][0], v1 = acc[ai][bj][3][1]; u32x4 w; w.x = pk2(v0[0], v0[1]); w.y = pk2(v0[2], v0[3]); w.z = pk2(v1[0], v1[1]); w.w = pk2(v1[2], v1[3]); *(u32x4*)(h + bj * NFF) = w;
                    if (co) { *(f32x4*)(co + bj * NFF) = v0; *(f32x4*)(co + bj * NFF + 4) = v1; } } }
        }
        __builtin_amdgcn_sched_barrier(0);
        f32x4 wa0[2], wa1[2], wa2[2], ba[2], wg0[2], wg1[2], wg2[2], bg[2];
#pragma unroll
        for (int n = 0; n < 2; ++n) { const int ch = f0 + 4 * n;
            wa0[n] = *(const f32x4*)(cw + ch); wa1[n] = *(const f32x4*)(cw + NUP + ch); wa2[n] = *(const f32x4*)(cw + 2 * NUP + ch); ba[n] = *(const f32x4*)(cb + ch);
            wg0[n] = *(const f32x4*)(cw + NFF + ch); wg1[n] = *(const f32x4*)(cw + NUP + NFF + ch); wg2[n] = *(const f32x4*)(cw + 2 * NUP + NFF + ch); bg[n] = *(const f32x4*)(cb + NFF + ch); }
#pragma unroll
        for (int ai = 0; ai < 2; ++ai)
#pragma unroll
            for (int m = 0; m < 4; ++m) { float r[8];
#pragma unroll
                for (int n = 0; n < 2; ++n)
#pragma unroll
                    for (int e = 0; e < 4; ++e) { const float A = acc[ai][0][m][n][e], Gv = acc[ai][1][m][n][e];
                        const float Ap = m > 0 ? acc[ai][0][m > 0 ? m - 1 : 0][n][e] : 0.f, Gp = m > 0 ? acc[ai][1][m > 0 ? m - 1 : 0][n][e] : 0.f;
                        const float a1 = dpp_prev(A, Ap, 1), a2 = dpp_prev(A, Ap, 2), g1 = dpp_prev(Gv, Gp, 1), g2 = dpp_prev(Gv, Gp, 2);
                        const float ca = ba[n][e] + wa0[n][e] * a2 + wa1[n][e] * a1 + wa2[n][e] * A, cg = bg[n][e] + wg0[n][e] * g2 + wg1[n][e] * g1 + wg2[n][e] * Gv;
                        r[4 * n + e] = silu(ca) * cg; }
                if (!(m == 0 && fr < 2)) { u32x4 w; w.x = pk2(r[0], r[1]); w.y = pk2(r[2], r[3]); w.z = pk2(r[4], r[5]); w.w = pk2(r[6], r[7]);
                    *(u32x4*)(ACT + (size_t)(rowt + ai * HALF + m * 16) * NFF + f0) = w; }
                __builtin_amdgcn_sched_barrier(0); }
    }
};
struct EpiUpConvS {
    bf16* ACT; float* out; const float* cw; const float* cb; const float* sbuf; LAS unsigned char* lds;
    __device__ __forceinline__ void operator()(f32x4 (&acc)[2][2][4][2], const Unit& u, int, int, int, int) const {
        const int tid = my_tid(lds), wid = __builtin_amdgcn_readfirstlane(tid >> 6), lane = tid & 63, wr = wid >> 2, wc = wid & 3, fr = lane & 15, fq = lane >> 4;
        const int f0 = u.pn * 128 + wc * 32 + 8 * fq, rowt = u.pm * BM + wr * 64 + fr;
        f32x4 wa0[2], wa1[2], wa2[2], ba[2], wg0[2], wg1[2], wg2[2], bg[2];
#pragma unroll
        for (int n = 0; n < 2; ++n) { const int ch = f0 + 4 * n;
            wa0[n] = *(const f32x4*)(cw + ch); wa1[n] = *(const f32x4*)(cw + NUP + ch); wa2[n] = *(const f32x4*)(cw + 2 * NUP + ch); ba[n] = *(const f32x4*)(cb + ch);
            wg0[n] = *(const f32x4*)(cw + NFF + ch); wg1[n] = *(const f32x4*)(cw + NUP + NFF + ch); wg2[n] = *(const f32x4*)(cw + 2 * NUP + NFF + ch); bg[n] = *(const f32x4*)(cb + NFF + ch); }
#pragma unroll
        for (int ai = 0; ai < 2; ++ai)
#pragma unroll
            for (int m = 0; m < 4; ++m) { const int bseq = (u.pm * BM + ai * HALF + wr * 64 + m * 16) >> 4;
                f32x4 sa[2], sg[2];
#pragma unroll
                for (int n = 0; n < 2; ++n) { sa[n] = (f32x4){0.f, 0.f, 0.f, 0.f}; sg[n] = sa[n]; }
                if (fr >= 14) { const float* sp = sbuf + (size_t)(bseq * 2 + (fr - 14)) * NUP + f0; float* co = out + O_SCONV + (size_t)(bseq * 2 + (fr - 14)) * NUP + f0;
#pragma unroll
                    for (int n = 0; n < 2; ++n) { sa[n] = *(const f32x4*)(sp + 4 * n); sg[n] = *(const f32x4*)(sp + NFF + 4 * n); *(f32x4*)(co + 4 * n) = acc[ai][0][m][n]; *(f32x4*)(co + NFF + 4 * n) = acc[ai][1][m][n]; } }
                float r[8];
#pragma unroll
                for (int n = 0; n < 2; ++n)
#pragma unroll
                    for (int e = 0; e < 4; ++e) { const float A = acc[ai][0][m][n][e], Gv = acc[ai][1][m][n][e];
                        const float a1 = dpp_prev(A, sa[n][e], 1), a2 = dpp_prev(A, sa[n][e], 2), g1 = dpp_prev(Gv, sg[n][e], 1), g2 = dpp_prev(Gv, sg[n][e], 2);
                        const float ca = ba[n][e] + wa0[n][e] * a2 + wa1[n][e] * a1 + wa2[n][e] * A, cg = bg[n][e] + wg0[n][e] * g2 + wg1[n][e] * g1 + wg2[n][e] * Gv;
                        r[4 * n + e] = silu(ca) * cg; }
                u32x4 w; w.x = pk2(r[0], r[1]); w.y = pk2(r[2], r[3]); w.z = pk2(r[4], r[5]); w.w = pk2(r[6], r[7]);
                *(u32x4*)(ACT + (size_t)(rowt + ai * HALF + m * 16) * NFF + f0) = w;
                __builtin_amdgcn_sched_barrier(0); }
    }
};
}

__device__ __forceinline__ int wt_row(int mode, int row_off, int n) { if (mode == 1) { const int g = n >= NFF, f = g ? n - NFF : n; return 256 * (f >> 7) + 128 * g + (f & 127); } return row_off + n; }
__device__ __forceinline__ void p0_transpose_item(const float* W, int K, int N, bf16* WT, float wsc, int row_off, LAS float* scr, int item, int lane, int mode = 0) {
    const int nblk = N / 32, kb = item / nblk, nb = item % nblk, k0 = 64 * kb, n0 = 32 * nb;
#pragma unroll
    for (int i = 0; i < 8; ++i) { const int idx = lane + 64 * i, kk = idx >> 3, n4 = idx & 7; const f32x4 v = *(const f32x4*)(W + (size_t)(k0 + kk) * N + n0 + 4 * n4) * wsc;
        LAS float* d = scr + kk * 33 + 4 * n4; d[0] = v.x; d[1] = v.y; d[2] = v.z; d[3] = v.w; }
    asm volatile("s_waitcnt lgkmcnt(0)" ::: "memory");
    const int c = lane & 7;
#pragma unroll
    for (int j = 0; j < 4; ++j) { const int n = (lane >> 3) + 8 * j; const LAS float* s = scr + (8 * c) * 33 + n;
        u32x4 o; o.x = pk2(s[0 * 33], s[1 * 33]); o.y = pk2(s[2 * 33], s[3 * 33]); o.z = pk2(s[4 * 33], s[5 * 33]); o.w = pk2(s[6 * 33], s[7 * 33]);
        *(u32x4*)(WT + (size_t)wt_row(mode, row_off, n0 + n) * K + k0 + 8 * c) = o; }
    asm volatile("s_waitcnt lgkmcnt(0)" ::: "memory");
}
__device__ __forceinline__ void rms_row_to_bf16(const float* xrow, const float* g, bf16* orow, int lane) {
    const f32x4* xr = (const f32x4*)xrow + lane; f32x4 v[4]; float s = 0.f;
#pragma unroll
    for (int j = 0; j < 4; ++j) { v[j] = xr[64 * j]; s += (v[j].x * v[j].x + v[j].y * v[j].y) + (v[j].z * v[j].z + v[j].w * v[j].w); }
    const float rstd = rsqrtf(wave_sum(s) * (1.f / DM) + EPS);
    u32x2* o8 = (u32x2*)orow + lane;
#pragma unroll
    for (int j = 0; j < 4; ++j) { const f32x4 gg = ((const f32x4*)g)[lane + 64 * j]; u32x2 w; w.x = pk2(v[j].x * rstd * gg.x, v[j].y * rstd * gg.y); w.y = pk2(v[j].z * rstd * gg.z, v[j].w * rstd * gg.w); o8[64 * j] = w; }
}
__device__ __forceinline__ void rms_row2_to_bf16(const float* x0, const float* x1, const float* g, bf16* o0, bf16* o1, int lane) {
    const f32x4* xr0 = (const f32x4*)x0 + lane; const f32x4* xr1 = (const f32x4*)x1 + lane; f32x4 v[4], w[4]; float s = 0.f, t = 0.f;
#pragma unroll
    for (int j = 0; j < 4; ++j) { v[j] = xr0[64 * j]; w[j] = xr1[64 * j]; }
#pragma unroll
    for (int j = 0; j < 4; ++j) { s += (v[j].x * v[j].x + v[j].y * v[j].y) + (v[j].z * v[j].z + v[j].w * v[j].w); t += (w[j].x * w[j].x + w[j].y * w[j].y) + (w[j].z * w[j].z + w[j].w * w[j].w); }
    const float r0 = rsqrtf(wave_sum(s) * (1.f / DM) + EPS), r1 = rsqrtf(wave_sum(t) * (1.f / DM) + EPS);
    u32x2* p0 = (u32x2*)o0 + lane; u32x2* p1 = (u32x2*)o1 + lane;
#pragma unroll
    for (int j = 0; j < 4; ++j) { const f32x4 gg = ((const f32x4*)g)[lane + 64 * j]; u32x2 a, b;
        a.x = pk2(v[j].x * r0 * gg.x, v[j].y * r0 * gg.y); a.y = pk2(v[j].z * r0 * gg.z, v[j].w * r0 * gg.w); b.x = pk2(w[j].x * r1 * gg.x, w[j].y * r1 * gg.y); b.y = pk2(w[j].z * r1 * gg.z, w[j].w * r1 * gg.w);
        p0[64 * j] = a; p1[64 * j] = b; }
}
__device__ __forceinline__ void rms_row_f32_inplace(float* xrow, const float* g, int lane) {
    f32x4* xr = (f32x4*)xrow + lane; f32x4 v[4]; float s = 0.f;
#pragma unroll
    for (int j = 0; j < 4; ++j) { v[j] = xr[64 * j]; s += (v[j].x * v[j].x + v[j].y * v[j].y) + (v[j].z * v[j].z + v[j].w * v[j].w); }
    const float rstd = rsqrtf(wave_sum(s) * (1.f / DM) + EPS);
#pragma unroll
    for (int j = 0; j < 4; ++j) { const f32x4 gg = ((const f32x4*)g)[lane + 64 * j]; xr[64 * j] = v[j] * rstd * gg; }
}

__device__ __forceinline__ void row_post(bf16* Z, bf16* CQN, bf16* CKV, bf16* KR, float* out, const float* qg, const float* kvg, int r, int lane) {
    bf16* z = Z + (size_t)r * NZ; const float pos = (float)row_pos(r);
    { const u32x2 raw = *(const u32x2*)(z + 4 * lane); const float v0 = bflo(raw.x), v1 = bfhi(raw.x), v2 = bflo(raw.y), v3 = bfhi(raw.y);
      const float rstd = rsqrtf(wave_sum((v0 * v0 + v1 * v1) + (v2 * v2 + v3 * v3)) * (1.f / 256.f) + EPS); const f32x4 g = *(const f32x4*)(qg + 4 * lane);
      u32x2 w; w.x = pk2(v0 * rstd * g.x, v1 * rstd * g.y); w.y = pk2(v2 * rstd * g.z, v3 * rstd * g.w); *(u32x2*)(CQN + (size_t)r * 256 + 4 * lane) = w; }
    { const unsigned raw = *(const unsigned*)(z + ZC_CKV + 2 * lane); const float v0 = bflo(raw), v1 = bfhi(raw);
      const float rstd = rsqrtf(wave_sum(v0 * v0 + v1 * v1) * (1.f / 128.f) + EPS); const f32x2 g = *(const f32x2*)(kvg + 2 * lane);
      const float y0 = v0 * rstd * g.x, y1 = v1 * rstd * g.y;
      float* o = (r < MP ? out + O_PCKV + (size_t)r * 128 : out + O_SCKV + (size_t)(r - MP) * 128) + 2 * lane; *(f32x2*)o = (f32x2){y0, y1};
      if (r < MP) *(unsigned*)(CKV + (size_t)r * 128 + 2 * lane) = pk2(y0, y1); }
    if (lane < 16) { const float x1 = bf2f(z[ZC_KR + lane]), x2 = bf2f(z[ZC_KR + 16 + lane]); const float inv = ex2f(-(float)lane * (2.0f / 32.0f) * LG2_10000);
      float s, c; sincos_rev(pos * inv, s, c); const float o1 = x1 * c - x2 * s, o2 = x2 * c + x1 * s;
      float* o = (r < MP ? out + O_PKR + (size_t)r * 32 : out + O_SKR + (size_t)(r - MP) * 32); o[lane] = o1; o[16 + lane] = o2;
      if (r < MP) { KR[(size_t)r * 32 + lane] = f2bf(o1); KR[(size_t)r * 32 + 16 + lane] = f2bf(o2); } }
    { const float inv = ex2f(-(float)lane * (1.0f / 63.0f) * LG2_10000); float s, c; sincos_rev(pos * inv, s, c);
#pragma unroll
      for (int hh = 0; hh < 4; ++hh) {
          bf16* q = z + ZC_RQ + hh * 128; const float a1 = bf2f(q[lane]), a2 = bf2f(q[64 + lane]); q[lane] = f2bf(a1 * c - a2 * s); q[64 + lane] = f2bf(a2 * c + a1 * s);
          bf16* k = z + ZC_RK + hh * 128; const float b1 = bf2f(k[lane]), b2 = bf2f(k[64 + lane]); const float ks = 0.08838834764831845f;
          k[lane] = f2bf((b1 * c - b2 * s) * ks); k[64 + lane] = f2bf((b2 * c + b1 * s) * ks); } }
}
__device__ __forceinline__ bf16x8 pack8(const f32x16& p, int b) {
    u32x4 w; w.x = pk2(p[b + 0], p[b + 1]); w.y = pk2(p[b + 2], p[b + 3]); w.z = pk2(p[b + 4], p[b + 5]); w.w = pk2(p[b + 6], p[b + 7]); return __builtin_bit_cast(bf16x8, w);
}
template <int DQK, int DV, int MODE>
__device__ __forceinline__ void flash_unit(LAS unsigned char* lds, const bf16* Qp, int qpitch, const bf16* K0, int kpitch, const bf16* K1, const bf16* VT, int vpitch,
                                           bf16* Op, int opitch, int NT, int jbase, int qpos0) {
    constexpr int KP = DQK + 8, VP = 68, KB = 64 * KP * 2, VB = DV * VP * 2, KCH = DQK / 8, NKC = 64 * KCH, KPT = (NKC + 511) / 512, NVC = DV * 8, VPT = NVC / 512, ND0 = DQK / 16, NDB = DV / 32;
    constexpr bool QREG = (MODE == 0);
    const int tid_ = my_tid(lds); const int tid = tid_, lane = tid & 63, r32 = lane & 31, hi = lane >> 5; const int wid = __builtin_amdgcn_readfirstlane(tid >> 6);
    const bf16* Qrow = Qp + (size_t)(wid * 32 + r32) * qpitch + 8 * hi;
    bf16x8 qf[QREG ? ND0 : 1];
    if constexpr (QREG) {
#pragma unroll
        for (int d0 = 0; d0 < ND0; ++d0) qf[d0] = *(const bf16x8*)(Qrow + 16 * d0);
        const float pos = (float)(qpos0 + wid * 32 + r32);
        const u32x4 xa = __builtin_bit_cast(u32x4, qf[ND0 - 2]), xb = __builtin_bit_cast(u32x4, qf[ND0 - 1]); u32x4 ra, rb;
#pragma unroll
        for (int e = 0; e < 4; ++e) { const float a0 = bflo(xa[e]), a1 = bfhi(xa[e]), b0 = bflo(xb[e]), b1 = bfhi(xb[e]);
            float s0_, c0_, s1_, c1_; sincos_rev(pos * ex2f(-(float)(8 * hi + 2 * e) * (2.0f / 32.0f) * LG2_10000), s0_, c0_); sincos_rev(pos * ex2f(-(float)(8 * hi + 2 * e + 1) * (2.0f / 32.0f) * LG2_10000), s1_, c1_);
            ra[e] = pk2(a0 * c0_ - b0 * s0_, a1 * c1_ - b1 * s1_); rb[e] = pk2(b0 * c0_ + a0 * s0_, b1 * c1_ + a1 * s1_); }
        qf[ND0 - 2] = __builtin_bit_cast(bf16x8, ra); qf[ND0 - 1] = __builtin_bit_cast(bf16x8, rb);
    }
    u32x4 kreg[KPT], vreg[VPT];
#define FL_GLOAD(j) do { \
    _Pragma("unroll") for (int i_ = 0; i_ < KPT; ++i_) { const int ci = tid + 512 * i_; if (ci < NKC) { const int key = ci / KCH, ch = ci - key * KCH; \
        const bf16* src; if (MODE == 0 && ch >= 8) src = K1 + (size_t)(64 * (j) + key) * 32 + (ch - 8) * 8; else src = K0 + (size_t)(64 * (j) + key) * kpitch + ch * 8; \
        kreg[i_] = *(const u32x4*)src; } } \
    _Pragma("unroll") for (int i_ = 0; i_ < VPT; ++i_) { const int ci = tid + 512 * i_; const int d = ci >> 3, ch = ci & 7; vreg[i_] = *(const u32x4*)(VT + (size_t)d * vpitch + 64 * (j) + ch * 8); } } while (0)
#define FL_LSTORE(buf) do { \
    _Pragma("unroll") for (int i_ = 0; i_ < KPT; ++i_) { const int ci = tid + 512 * i_; if (ci < NKC) { const int key = ci / KCH, ch = ci - key * KCH; \
        *(LAS u32x4*)(lds + (buf) * KB + (key * KP + ch * 8) * 2) = kreg[i_]; } } \
    _Pragma("unroll") for (int i_ = 0; i_ < VPT; ++i_) { const int ci = tid + 512 * i_; const int d = ci >> 3, ch = ci & 7; LAS u32x2* p_ = (LAS u32x2*)(lds + 2 * KB + (buf) * VB + (d * VP + ch * 8) * 2); \
        p_[0] = (u32x2){vreg[i_].x, vreg[i_].y}; p_[1] = (u32x2){vreg[i_].z, vreg[i_].w}; } } while (0)
#define FL_GLOADK(j) do { \
    _Pragma("unroll") for (int i_ = 0; i_ < KPT; ++i_) { const int ci = tid + 512 * i_; if (ci < NKC) { const int key = ci / KCH, ch = ci - key * KCH; \
        kreg[i_] = *(const u32x4*)(K0 + (size_t)(64 * (j) + key) * kpitch + ch * 8); } } } while (0)
#define FL_LSTOREK(buf) do { \
    _Pragma("unroll") for (int i_ = 0; i_ < KPT; ++i_) { const int ci = tid + 512 * i_; if (ci < NKC) { const int key = ci / KCH, ch = ci - key * KCH; \
        *(LAS u32x4*)(lds + (buf) * KB + (key * KP + ch * 8) * 2) = kreg[i_]; } } } while (0)
#define FL_GLOADV(j) do { \
    _Pragma("unroll") for (int i_ = 0; i_ < VPT; ++i_) { const int ci = tid + 512 * i_; const int d = ci >> 3, ch = ci & 7; kreg[i_] = *(const u32x4*)(VT + (size_t)d * vpitch + 64 * (j) + ch * 8); } } while (0)
#define FL_LSTOREV(buf) do { \
    _Pragma("unroll") for (int i_ = 0; i_ < VPT; ++i_) { const int ci = tid + 512 * i_; const int d = ci >> 3, ch = ci & 7; LAS u32x2* p_ = (LAS u32x2*)(lds + 2 * KB + (buf) * VB + (d * VP + ch * 8) * 2); \
        p_[0] = (u32x2){kreg[i_].x, kreg[i_].y}; p_[1] = (u32x2){kreg[i_].z, kreg[i_].w}; } } while (0)
    static_assert(MODE == 0 || VPT <= KPT, "MODE 1 stages V through the K registers");
    f32x16 o[NDB];
#pragma unroll
    for (int i = 0; i < NDB; ++i)
#pragma unroll
        for (int r = 0; r < 16; ++r) o[i][r] = 0.f;
    float mref = 0.f, lrun = 0.f;
    const int jmax = jbase + (wid >> 1);
    FL_GLOAD(0); FL_LSTORE(0); __syncthreads();
    f32x16 s0, s1, negt;
#pragma unroll
    for (int r = 0; r < 16; ++r) negt[r] = 0.f;
#define FL_X(tj) do { \
        if constexpr (MODE != 0) { const float negm = -mref; _Pragma("unroll") for (int r = 0; r < 16; ++r) { s0[r] = negm; s1[r] = negm; } } \
        const LAS unsigned char* kb = lds + ((tj) & 1) * KB + (r32 * KP + 8 * hi) * 2; \
        constexpr int GD = (ND0 <= 6) ? ND0 : 2; \
        _Pragma("unroll") for (int g0 = 0; g0 < ND0; g0 += GD) { \
            bf16x8 ka[GD], kc[GD], qq[GD]; \
            _Pragma("unroll") for (int i = 0; i < GD; ++i) { ka[i] = *(const LAS bf16x8*)(kb + (g0 + i) * 32); kc[i] = *(const LAS bf16x8*)(kb + 32 * KP * 2 + (g0 + i) * 32); \
                if constexpr (QREG) qq[i] = qf[g0 + i]; else qq[i] = *(const bf16x8*)(Qrow + 16 * (g0 + i)); } \
            __builtin_amdgcn_sched_barrier(0); \
            _Pragma("unroll") for (int i = 0; i < GD; ++i) { if (MODE == 0 && g0 == 0 && i == 0) { s0 = MFMA32(ka[i], qq[i], negt); s1 = MFMA32(kc[i], qq[i], negt); } else { s0 = MFMA32(ka[i], qq[i], s0); s1 = MFMA32(kc[i], qq[i], s1); } } \
            __builtin_amdgcn_sched_barrier(0); \
        } } while (0)
#define FL_Y(tj) do { \
        const LAS unsigned char* vb = lds + 2 * KB + ((tj) & 1) * VB + (r32 * VP + 4 * hi) * 2; \
        constexpr int VPRE = NDB <= 4 ? NDB : 1;     \
        u32x2 vl[VPRE * 4], vh[VPRE * 4]; \
        _Pragma("unroll") for (int db = 0; db < VPRE; ++db) _Pragma("unroll") for (int ks = 0; ks < 4; ++ks) { const LAS unsigned char* vp = vb + (db * 32 * VP + 16 * ks) * 2; vl[db * 4 + ks] = *(const LAS u32x2*)vp; vh[db * 4 + ks] = *(const LAS u32x2*)(vp + 16); } \
        __builtin_amdgcn_sched_barrier(0); \
        float mxa = fmaxf(fmaxf(s0[0], s0[1]), s0[2]), mxb = fmaxf(fmaxf(s1[0], s1[1]), s1[2]); \
        _Pragma("unroll") for (int r = 3; r < 15; r += 2) { mxa = fmaxf(fmaxf(mxa, s0[r]), s0[r + 1]); mxb = fmaxf(fmaxf(mxb, s1[r]), s1[r + 1]); } \
        float mx = fmaxf(fmaxf(mxa, s0[15]), fmaxf(mxb, s1[15])); \
        mx = half_max(mx); \
        if ((tj) == 0 || __any(mx > 8.0f)) { \
            const float dl = ((tj) == 0 || mx > 8.0f) ? mx : 0.f; mref += dl; \
            const float al = __builtin_amdgcn_exp2f(-dl); lrun *= al; \
            if constexpr (MODE == 0) { const float nm_ = -mref; _Pragma("unroll") for (int r = 0; r < 16; ++r) negt[r] = nm_; } \
            _Pragma("unroll") for (int r = 0; r < 16; ++r) { s0[r] -= dl; s1[r] -= dl; } \
            _Pragma("unroll") for (int i = 0; i < NDB; ++i) _Pragma("unroll") for (int r = 0; r < 16; ++r) o[i][r] *= al; \
        } \
        float ls = 0.f; \
        _Pragma("unroll") for (int r = 0; r < 16; ++r) { s0[r] = __builtin_amdgcn_exp2f(s0[r]); s1[r] = __builtin_amdgcn_exp2f(s1[r]); ls += s0[r] + s1[r]; } \
        lrun += ls; \
        bf16x8 pf[4]; pf[0] = pack8(s0, 0); pf[1] = pack8(s0, 8); pf[2] = pack8(s1, 0); pf[3] = pack8(s1, 8); \
        __builtin_amdgcn_sched_barrier(0); \
        _Pragma("unroll") for (int db = 0; db < VPRE; ++db) _Pragma("unroll") for (int ks = 0; ks < 4; ++ks) { \
            const u32x4 v4 = (u32x4){vl[db * 4 + ks].x, vl[db * 4 + ks].y, vh[db * 4 + ks].x, vh[db * 4 + ks].y}; \
            o[db] = MFMA32(__builtin_bit_cast(bf16x8, v4), pf[ks], o[db]); } \
        _Pragma("unroll") for (int d2 = VPRE; d2 < NDB; ++d2) { u32x2 wl[4], wh[4]; \
            _Pragma("unroll") for (int q = 0; q < 4; ++q) { const LAS unsigned char* vp = vb + (d2 * 32 * VP + 16 * q) * 2; wl[q] = *(const LAS u32x2*)vp; wh[q] = *(const LAS u32x2*)(vp + 16); } \
            __builtin_amdgcn_sched_barrier(0); \
            _Pragma("unroll") for (int q = 0; q < 4; ++q) { const u32x4 v4 = (u32x4){wl[q].x, wl[q].y, wh[q].x, wh[q].y}; o[d2] = MFMA32(__builtin_bit_cast(bf16x8, v4), pf[q], o[d2]); } \
            __builtin_amdgcn_sched_barrier(0); } } while (0)
    for (int j = 0; j < NT; ++j) {
        const int buf = j & 1;
        if (j + 1 < NT) { if constexpr (MODE == 1) { FL_GLOADK(j + 1); FL_LSTOREK(buf ^ 1); FL_GLOADV(j + 1); FL_LSTOREV(buf ^ 1); } else { FL_GLOAD(j + 1); } }
        if (MODE == 1 || j <= jmax) { FL_X(j); FL_Y(j); }
        if constexpr (MODE == 0) { if (j + 1 < NT) { FL_LSTORE(buf ^ 1); } }
        __syncthreads();
    }
#undef FL_X
#undef FL_Y
    { const float lt = half_sum(lrun), inv = 1.f / lt;
      bf16* orow = Op + (size_t)(wid * 32 + r32) * opitch + 4 * hi;
#pragma unroll
      for (int db = 0; db < NDB; ++db)
#pragma unroll
          for (int rg = 0; rg < 4; ++rg) { u32x2 w; w.x = pk2(o[db][4 * rg] * inv, o[db][4 * rg + 1] * inv); w.y = pk2(o[db][4 * rg + 2] * inv, o[db][4 * rg + 3] * inv);
              *(u32x2*)(orow + 32 * db + 8 * rg) = w; } }
#undef FL_GLOAD
#undef FL_LSTORE
#undef FL_GLOADK
#undef FL_LSTOREK
#undef FL_GLOADV
#undef FL_LSTOREV
}

__device__ __forceinline__ void ret_kv_item(LAS unsigned char* lds, const bf16* Z, bf16* AT, int b, int c, int hh, float lg) {
    LAS bf16* KT = (LAS bf16*)lds; LAS bf16* VTt = KT + 128 * 72;
    const int tid_ = my_tid(lds); const int tid = tid_, lane = tid & 63, r32 = lane & 31, hi = lane >> 5; const int wid = __builtin_amdgcn_readfirstlane(tid >> 6);
    const int rowbase = b * SEQ + 64 * c;
#pragma unroll
    for (int i = 0; i < 2; ++i) { const int ci = tid + 512 * i, l = ci & 63, dc = ci >> 6; const bf16* zr = Z + (size_t)(rowbase + l) * NZ + hh * 128 + dc * 8;
        const u32x4 kr = *(const u32x4*)(zr + ZC_RK), vr = *(const u32x4*)(zr + ZC_RV); const float dec = ex2f((float)(63 - l) * lg);
#pragma unroll
        for (int e = 0; e < 4; ++e) { const unsigned kw = kr[e], vw = vr[e]; const int d = 8 * dc + 2 * e;
            KT[d * 72 + l] = f2bf(bflo(kw) * dec); KT[(d + 1) * 72 + l] = f2bf(bfhi(kw) * dec);
            VTt[d * 72 + l] = (bf16)(vw & 0xffffu); VTt[(d + 1) * 72 + l] = (bf16)(vw >> 16); } }
    __syncthreads();
    const int eb = wid >> 1, db0 = 2 * (wid & 1);
    f32x16 a0, a1;
#pragma unroll
    for (int r = 0; r < 16; ++r) { a0[r] = 0.f; a1[r] = 0.f; }
#pragma unroll
    for (int ks = 0; ks < 4; ++ks) {
        const bf16x8 af = *(const LAS bf16x8*)(VTt + (32 * eb + r32) * 72 + 16 * ks + 8 * hi);
        const bf16x8 b0 = *(const LAS bf16x8*)(KT + (32 * db0 + r32) * 72 + 16 * ks + 8 * hi), b1 = *(const LAS bf16x8*)(KT + (32 * db0 + 32 + r32) * 72 + 16 * ks + 8 * hi);
        a0 = MFMA32(af, b0, a0); a1 = MFMA32(af, b1, a1);
    }
    bf16* o = AT + (size_t)((b * 256 + c) * 4 + hh) * 16384;
#pragma unroll
    for (int r = 0; r < 16; ++r) { const int e = 32 * eb + crow(r, hi); o[e * 128 + 32 * db0 + r32] = f2bf(a0[r]); o[e * 128 + 32 * db0 + 32 + r32] = f2bf(a1[r]); }
    __syncthreads();
}
__device__ __forceinline__ void ret_scan(LAS unsigned char* lds, bf16* AT, float* out, int G, const float* lgs) {
    const int t_ = my_tid(lds);
    for (int idx = blockIdx.x * 512 + t_; idx < 2 * 4 * 128 * 128; idx += G * 512) {
        const int d = idx & 127, e = (idx >> 7) & 127, hh = (idx >> 14) & 3, b = idx >> 16;
        const float g64 = ex2f(64.f * lgs[hh]);
        bf16* p = AT + (size_t)(b * 256 * 4 + hh) * 16384 + e * 128 + d; float S = 0.f;
        for (int c = 0; c < 256; c += 8) { float a[8];
#pragma unroll
            for (int i = 0; i < 8; ++i) a[i] = bf2f(p[(size_t)(c + i) * 65536]);
#pragma unroll
            for (int i = 0; i < 8; ++i) { p[(size_t)(c + i) * 65536] = f2bf(S); S = g64 * S + a[i]; } }
        out[O_PRET + (size_t)((b * 4 + hh) * 128 + d) * 128 + e] = S;
    }
}
__device__ __forceinline__ void ret_out_item(LAS unsigned char* lds, const bf16* Z, const bf16* AT, const float* gn, bf16* MIXED, int b, int c, const float* lgs) {
    LAS bf16* VT4 = (LAS bf16*)lds;
    const int tid_ = my_tid(lds); const int tid = tid_, lane = tid & 63, r32 = lane & 31, hi = lane >> 5; const int wid = __builtin_amdgcn_readfirstlane(tid >> 6);
    const int rowbase = b * SEQ + 64 * c;
#pragma unroll
    for (int i = 0; i < 8; ++i) { const int ci = tid + 512 * i, l = ci & 63, ec = ci >> 6; const u32x4 vr = *(const u32x4*)(Z + (size_t)(rowbase + l) * NZ + ZC_RV + ec * 8);
#pragma unroll
        for (int e = 0; e < 4; ++e) { const unsigned vw = vr[e]; VT4[(8 * ec + 2 * e) * 72 + l] = (bf16)(vw & 0xffffu); VT4[(8 * ec + 2 * e + 1) * 72 + l] = (bf16)(vw >> 16); } }
    __syncthreads();
    const int hh = wid >> 1, lb = wid & 1, l = 32 * lb + r32, row = rowbase + l; const float lg = lgs[hh];
    bf16x8 qf[8];
#pragma unroll
    for (int ds = 0; ds < 8; ++ds) qf[ds] = *(const bf16x8*)(Z + (size_t)row * NZ + ZC_RQ + hh * 128 + 16 * ds + 8 * hi);
    f32x16 acc[4];
#pragma unroll
    for (int i = 0; i < 4; ++i)
#pragma unroll
        for (int r = 0; r < 16; ++r) acc[i][r] = 0.f;
    const bf16* Sp = AT + (size_t)((b * 256 + c) * 4 + hh) * 16384;
#pragma unroll
    for (int eb = 0; eb < 4; ++eb)
#pragma unroll
        for (int ds = 0; ds < 8; ++ds) { const bf16x8 w = *(const bf16x8*)(Sp + (32 * eb + r32) * 128 + 16 * ds + 8 * hi);
            acc[eb] = MFMA32(w, qf[ds], acc[eb]); if (ds == 3 || ds == 7) __builtin_amdgcn_sched_barrier(0); }
    { const float qd = ex2f((float)(l + 1) * lg);
#pragma unroll
      for (int i = 0; i < 4; ++i)
#pragma unroll
          for (int r = 0; r < 16; ++r) acc[i][r] *= qd; }
#pragma unroll
    for (int mb = 0; mb < 2; ++mb) {
        if (mb <= lb) {
            f32x16 st;
#pragma unroll
            for (int r = 0; r < 16; ++r) st[r] = 0.f;
#pragma unroll
            for (int ds = 0; ds < 8; ++ds) { const bf16x8 kf = *(const bf16x8*)(Z + (size_t)(rowbase + 32 * mb + r32) * NZ + ZC_RK + hh * 128 + 16 * ds + 8 * hi); st = MFMA32(kf, qf[ds], st); }
#pragma unroll
            for (int r = 0; r < 16; ++r) { const int m = 32 * mb + crow(r, hi), diff = l - m; st[r] = diff >= 0 ? st[r] * ex2f((float)diff * lg) : 0.f; }
            const bf16x8 pf0 = pack8(st, 0), pf1 = pack8(st, 8);
#pragma unroll
            for (int eb = 0; eb < 4; ++eb)
#pragma unroll
                for (int kk = 0; kk < 2; ++kk) { const LAS bf16* vp = VT4 + (hh * 128 + 32 * eb + r32) * 72 + 16 * (2 * mb + kk) + 4 * hi;
                    const u32x2 lo = *(const LAS u32x2*)vp, h2 = *(const LAS u32x2*)(vp + 8); const u32x4 v4 = (u32x4){lo.x, lo.y, h2.x, h2.y};
                    acc[eb] = MFMA32(__builtin_bit_cast(bf16x8, v4), kk ? pf1 : pf0, acc[eb]); }
        }
    }
    float s = 0.f;
#pragma unroll
    for (int i = 0; i < 4; ++i)
#pragma unroll
        for (int r = 0; r < 16; ++r) s += acc[i][r];
    s = half_sum(s); const float mean = s * (1.f / 128.f); float v = 0.f;
#pragma unroll
    for (int i = 0; i < 4; ++i)
#pragma unroll
        for (int r = 0; r < 16; ++r) { const float dd = acc[i][r] - mean; v += dd * dd; }
    v = half_sum(v); const float rstd = rsqrtf(v * (1.f / 128.f) + EPS);
#pragma unroll
    for (int eb = 0; eb < 4; ++eb)
#pragma unroll
        for (int rg = 0; rg < 4; ++rg) { const int e0 = 32 * eb + 8 * rg + 4 * hi;
            const u32x2 gt = *(const u32x2*)(Z + (size_t)row * NZ + ZC_RG + hh * 128 + e0); const f32x4 gg = *(const f32x4*)(gn + hh * 128 + e0);
            const float y0 = (acc[eb][4 * rg] - mean) * rstd * gg.x * silu(bflo(gt.x)), y1 = (acc[eb][4 * rg + 1] - mean) * rstd * gg.y * silu(bfhi(gt.x));
            const float y2 = (acc[eb][4 * rg + 2] - mean) * rstd * gg.z * silu(bflo(gt.y)), y3 = (acc[eb][4 * rg + 3] - mean) * rstd * gg.w * silu(bfhi(gt.y));
            u32x2 w; w.x = pk2(y0, y1); w.y = pk2(y2, y3); *(u32x2*)(MIXED + (size_t)row * 1024 + 512 + hh * 128 + e0) = w; }
    __syncthreads();
}
__device__ __forceinline__ void ret_sample_item(LAS unsigned char* lds, const bf16* Z, const float* S0, const float* gn, float* out, bf16* MIXED, int b, int hh, float lg) {
    LAS float* qT = (LAS float*)lds;
    LAS float* kT = qT + 2048;
    LAS float* vS = kT + 2048;
    LAS float* inn = vS + 2048;
    LAS float* QSp = inn + 256;
    LAS float* oS = QSp + 8192;
    const int tid_ = my_tid(lds); const int tid = tid_, lane = tid & 63; const int wid = __builtin_amdgcn_readfirstlane(tid >> 6);
    const int rowbase = MP + b * 16;
#pragma unroll
    for (int i = 0; i < 4; ++i) { const int idx = tid + 512 * i, l = idx >> 7, d = idx & 127; const bf16* zr = Z + (size_t)(rowbase + l) * NZ + hh * 128 + d;
        qT[d * 16 + l] = bf2f(zr[ZC_RQ]); kT[d * 16 + l] = bf2f(zr[ZC_RK]); vS[l * 128 + d] = bf2f(zr[ZC_RV]); }
    __syncthreads();
    if (tid < 256) { const int l = tid >> 4, m = tid & 15; float s = 0.f;
        if (m <= l) { for (int d = 0; d < 128; ++d) s += qT[d * 16 + l] * kT[d * 16 + m]; s *= ex2f((float)(l - m) * lg); }
        inn[l * 16 + m] = s; }
    { const int e = tid & 127, dg = tid >> 7; float vr[16], qs[16], gk[16];
#pragma unroll
      for (int l = 0; l < 16; ++l) { vr[l] = vS[l * 128 + e]; qs[l] = 0.f; gk[l] = ex2f((float)(15 - l) * lg); }
      const float g16 = ex2f(16.f * lg); const size_t sb = (size_t)((b * 4 + hh) * 128) * 128;
      for (int dd = 0; dd < 32; ++dd) { const int d = dg * 32 + dd; const float s0 = S0[sb + (size_t)d * 128 + e]; float kv = 0.f;
#pragma unroll
          for (int l4 = 0; l4 < 4; ++l4) { const f32x4 k4 = *(const LAS f32x4*)(kT + d * 16 + 4 * l4), q4 = *(const LAS f32x4*)(qT + d * 16 + 4 * l4);
#pragma unroll
              for (int j = 0; j < 4; ++j) { kv += k4[j] * gk[4 * l4 + j] * vr[4 * l4 + j]; qs[4 * l4 + j] += q4[j] * s0; } }
          out[O_SRET + sb + (size_t)d * 128 + e] = g16 * s0 + kv; }
#pragma unroll
      for (int l = 0; l < 16; ++l) QSp[(dg * 16 + l) * 128 + e] = qs[l]; }
    __syncthreads();
    { const int e = tid & 127, lgp = tid >> 7;
#pragma unroll
      for (int li = 0; li < 4; ++li) { const int l = 4 * lgp + li; float a = (QSp[(0 * 16 + l) * 128 + e] + QSp[(1 * 16 + l) * 128 + e]) + (QSp[(2 * 16 + l) * 128 + e] + QSp[(3 * 16 + l) * 128 + e]);
          a *= ex2f((float)(l + 1) * lg);
          for (int m = 0; m <= l; ++m) a += inn[l * 16 + m] * vS[m * 128 + e];
          oS[l * 128 + e] = a; } }
    __syncthreads();
#pragma unroll
    for (int li = 0; li < 2; ++li) { const int l = 2 * wid + li, row = rowbase + l; const float x0 = oS[l * 128 + lane], x1 = oS[l * 128 + 64 + lane];
        const float mean = wave_sum(x0 + x1) * (1.f / 128.f); const float d0 = x0 - mean, d1 = x1 - mean; const float rstd = rsqrtf(wave_sum(d0 * d0 + d1 * d1) * (1.f / 128.f) + EPS);
        const bf16* zg = Z + (size_t)row * NZ + ZC_RG + hh * 128; bf16* mo = MIXED + (size_t)row * 1024 + 512 + hh * 128;
        mo[lane] = f2bf(d0 * rstd * gn[hh * 128 + lane] * silu(bf2f(zg[lane]))); mo[64 + lane] = f2bf(d1 * rstd * gn[hh * 128 + 64 + lane] * silu(bf2f(zg[64 + lane]))); }
    __syncthreads();
}
constexpr int AS_NK = PAST + 16, AS_NT = (AS_NK + 63) / 64;
__device__ __forceinline__ void mla_sample_unit(LAS unsigned char* lds, size_t ws_q, size_t ws_olat, size_t ws_mixed, int b) {
    constexpr int DQK = 160, DV = 128, KP = DQK + 8, VP = 68, KB = 64 * KP * 2, VB = DV * VP * 2, ND0 = DQK / 16, NDB = DV / 32, QA_BYTES = 128 * KP * 2, KV0 = QA_BYTES, QS_OFF = QA_BYTES;
    const int tid_ = my_tid(lds); const int tid = tid_, lane = tid & 63, r32 = lane & 31, hi = lane >> 5; const int wid = __builtin_amdgcn_readfirstlane(tid >> 6);
    LAS float* QS = (LAS float*)(lds + QS_OFF);
    const int rowbase = MP + b * 16;
    { const bf16* Q = WSB(ws_q); const float* w_uk = INP(14); LAS bf16* QA = (LAS bf16*)lds;
#pragma unroll
    for (int i = 0; i < 24; ++i) { const int idx = tid + 512 * i, t = idx / 768, c = idx - t * 768; QS[idx] = bf2f(Q[(size_t)(rowbase + t) * 768 + c]); }
    __syncthreads();
    { const int r = tid & 127, hg = tid >> 7;
#pragma unroll 1
      for (int h2 = 0; h2 < 2; ++h2) { const int h = 2 * hg + h2; const float* wr = w_uk + (size_t)(r * 8 + h) * 64; float a[16];
#pragma unroll
          for (int t = 0; t < 16; ++t) a[t] = 0.f;
#pragma unroll 4
          for (int d4 = 0; d4 < 16; ++d4) { const f32x4 w = *(const f32x4*)(wr + 4 * d4);
#pragma unroll
              for (int t = 0; t < 16; ++t) { const f32x4 q = *(const LAS f32x4*)(QS + t * 768 + h * 96 + 4 * d4); a[t] += (w.x * q.x + w.y * q.y) + (w.z * q.z + w.w * q.w); } }
#pragma unroll
          for (int t = 0; t < 16; ++t) QA[(h * 16 + t) * KP + r] = f2bf(a[t]); }
#pragma unroll
      for (int i = 0; i < 8; ++i) { const int idx = tid + 512 * i, row = idx >> 5, i32 = idx & 31, ii = i32 & 15, h = row >> 4, t = row & 15;
          const float x1 = QS[t * 768 + h * 96 + 64 + ii], x2 = QS[t * 768 + h * 96 + 80 + ii]; float sn, cs; sincos_rev((float)(PAST + t) * ex2f(-(float)ii * (2.0f / 32.0f) * LG2_10000), sn, cs);
          QA[row * KP + 128 + i32] = f2bf(i32 < 16 ? x1 * cs - x2 * sn : x2 * cs + x1 * sn); } }
    }
    __syncthreads();
    const float *c_ckv = INP(2), *c_kr = INP(3); const float* n_ckv = OUTP() + O_SCKV; const float* n_kr = OUTP() + O_SKR;
    const LAS unsigned char* qb_ = lds + (((wid & 3) * 32 + r32) * KP + 8 * hi) * 2;
    f32x4 pre[10];
#define AS_GLOAD(pi) do { _Pragma("unroll") for (int i_ = 0; i_ < 10; ++i_) { const int cj = tl + 512 * i_, sl = cj >= 2560, ci = cj - 2560 * sl, key = (ci & 15) + 16 * ((ci >> 6) & 3), ch = ((ci >> 4) & 3) + 4 * (ci >> 8), kg = 64 * (2 * (pi) + sl) + key; \
        const float* src = kg < PAST ? (ch < 32 ? c_ckv + ((size_t)(b * PAST + kg) * 128 + 4 * ch) : c_kr + ((size_t)(b * PAST + kg) * 32 + 4 * (ch - 32))) \
                                     : (ch < 32 ? n_ckv + ((size_t)(b * 16 + (kg - PAST)) * 128 + 4 * ch) : n_kr + ((size_t)(b * 16 + (kg - PAST)) * 32 + 4 * (ch - 32))); \
        pre[i_] = kg < AS_NK ? *(const f32x4*)src : (f32x4){0.f, 0.f, 0.f, 0.f}; } } while (0)
#define AS_LSTORE() do { _Pragma("unroll") for (int i_ = 0; i_ < 10; ++i_) { const int cj = tl + 512 * i_, sl = cj >= 2560, ci = cj - 2560 * sl, key = (ci & 15) + 16 * ((ci >> 6) & 3), ch = ((ci >> 4) & 3) + 4 * (ci >> 8); \
        const unsigned w0_ = pk2(pre[i_].x, pre[i_].y), w1_ = pk2(pre[i_].z, pre[i_].w); \
        *(LAS u32x2*)(lds + KV0 + sl * KB + (key * KP + 4 * ch) * 2) = (u32x2){w0_, w1_}; \
        if (ch < 32) { LAS bf16* vt_ = (LAS bf16*)(lds + KV0 + 2 * KB + sl * VB) + (4 * ch) * VP + key; \
            vt_[0] = (bf16)(w0_ & 0xffffu); vt_[VP] = (bf16)(w0_ >> 16); vt_[2 * VP] = (bf16)(w1_ & 0xffffu); vt_[3 * VP] = (bf16)(w1_ >> 16); } } } while (0)
    f32x16 o[NDB];
#pragma unroll
    for (int i = 0; i < NDB; ++i)
#pragma unroll
        for (int r = 0; r < 16; ++r) o[i][r] = 0.f;
    float mref = 0.f, lrun = 0.f;
    int tl = tid; asm volatile("" : "+v"(tl));
    AS_GLOAD(0); AS_LSTORE(); __syncthreads();
    const int grp = wid >> 2;
    for (int pi = 0; pi < (AS_NT + 1) / 2; ++pi) {
        const int j = 2 * pi + grp, buf = grp;
        asm volatile("" : "+v"(tl));
        if (2 * pi + 2 < AS_NT) AS_GLOAD(pi + 1);
        if (j < AS_NT) {
            f32x16 s0, s1;
            { const float negm = -mref;
#pragma unroll
              for (int r = 0; r < 16; ++r) { s0[r] = negm; s1[r] = negm; } }
            const LAS unsigned char* kb = lds + KV0 + buf * KB + (r32 * KP + 8 * hi) * 2;
#pragma unroll
            for (int g0 = 0; g0 < ND0; ++g0) {
                const bf16x8 ka = *(const LAS bf16x8*)(kb + g0 * 32), kc = *(const LAS bf16x8*)(kb + 32 * KP * 2 + g0 * 32), qq = *(const LAS bf16x8*)(qb_ + g0 * 32);
                s0 = MFMA32(ka, qq, s0); s1 = MFMA32(kc, qq, s1);
            }
            if (j == AS_NT - 1) {
#pragma unroll
                for (int r = 0; r < 16; ++r) { if (crow(r, hi) >= AS_NK - 64 * (AS_NT - 1)) s0[r] = -INFINITY; if (32 + crow(r, hi) >= AS_NK - 64 * (AS_NT - 1)) s1[r] = -INFINITY; }
            }
            float mx = fmaxf(fmaxf(s0[0], s1[0]), fmaxf(s0[1], s1[1]));
#pragma unroll
            for (int r = 2; r < 16; r += 2) mx = fmaxf(mx, fmaxf(fmaxf(s0[r], s1[r]), fmaxf(s0[r + 1], s1[r + 1])));
            { auto rr = __builtin_amdgcn_permlane32_swap(__float_as_uint(mx), __float_as_uint(mx), false, false); mx = fmaxf(__uint_as_float(rr[0]), __uint_as_float(rr[1])); }
            if (pi == 0 || __any(mx > 8.0f)) {
                const float dl = (pi == 0 || mx > 8.0f) ? mx : 0.f; mref += dl;
                const float al = __builtin_amdgcn_exp2f(-dl); lrun *= al;
#pragma unroll
                for (int r = 0; r < 16; ++r) { s0[r] -= dl; s1[r] -= dl; }
#pragma unroll
                for (int i = 0; i < NDB; ++i)
#pragma unroll
                    for (int r = 0; r < 16; ++r) o[i][r] *= al;
            }
            float ls = 0.f;
#pragma unroll
            for (int r = 0; r < 16; ++r) { s0[r] = __builtin_amdgcn_exp2f(s0[r]); s1[r] = __builtin_amdgcn_exp2f(s1[r]); ls += s0[r] + s1[r]; }
            lrun += ls;
            bf16x8 pf[4]; pf[0] = pack8(s0, 0); pf[1] = pack8(s0, 8); pf[2] = pack8(s1, 0); pf[3] = pack8(s1, 8);
            const LAS unsigned char* vb = lds + KV0 + 2 * KB + buf * VB + (r32 * VP + 4 * hi) * 2;
#pragma unroll
            for (int dp = 0; dp < NDB; ++dp) {
                u32x2 vl[4], vh[4];
#pragma unroll
                for (int q = 0; q < 4; ++q) { const LAS unsigned char* vp = vb + (dp * 32 * VP + 16 * q) * 2; vl[q] = *(const LAS u32x2*)vp; vh[q] = *(const LAS u32x2*)(vp + 16); }
#pragma unroll
                for (int q = 0; q < 4; ++q) { const u32x4 v4 = (u32x4){vl[q].x, vl[q].y, vh[q].x, vh[q].y}; o[dp] = MFMA32(__builtin_bit_cast(bf16x8, v4), pf[q], o[dp]); }
            }
        }
        __syncthreads();
        if (2 * pi + 2 < AS_NT) { AS_LSTORE(); }
        __syncthreads();
    }
#undef AS_GLOAD
#undef AS_LSTORE
    { LAS float* MG = (LAS float*)(lds + KV0) + ((wid & 3) * 64 + lane) * 67;
      if (grp == 1) { MG[0] = mref; MG[1] = lrun;
#pragma unroll
          for (int i = 0; i < NDB; ++i)
#pragma unroll
              for (int r = 0; r < 16; ++r) MG[2 + i * 16 + r] = o[i][r]; }
      __syncthreads();
      if (grp == 0) { const float m1 = MG[0], l1 = MG[1], mm = fmaxf(mref, m1), f0 = __builtin_amdgcn_exp2f(mref - mm), f1 = __builtin_amdgcn_exp2f(m1 - mm);
          lrun = lrun * f0 + l1 * f1;
#pragma unroll
          for (int i = 0; i < NDB; ++i)
#pragma unroll
              for (int r = 0; r < 16; ++r) o[i][r] = o[i][r] * f0 + MG[2 + i * 16 + r] * f1; }
      __syncthreads(); }
    if (wid < 4) { const float lt = half_sum(lrun), inv = 1.f / lt; bf16* OLAT = WSB(ws_olat);
        bf16* orow = OLAT + (size_t)(b * 128 + wid * 32 + r32) * 128 + 4 * hi;
#pragma unroll
        for (int db = 0; db < NDB; ++db)
#pragma unroll
            for (int rg = 0; rg < 4; ++rg) { u32x2 w; w.x = pk2(o[db][4 * rg] * inv, o[db][4 * rg + 1] * inv); w.y = pk2(o[db][4 * rg + 2] * inv, o[db][4 * rg + 3] * inv);
                *(u32x2*)(orow + 32 * db + 8 * rg) = w; } }
    __threadfence(); __syncthreads();
    { LAS float* OLT = (LAS float*)(lds + KV0);
      const bf16* OLAT = WSB(ws_olat); const float* w_uv = INP(15); bf16* MIXED = WSB(ws_mixed);
#pragma unroll
      for (int i = 0; i < 4; ++i) { const int idx = tid + 512 * i, row = idx >> 4, c8 = idx & 15; const u32x4 v = *(const u32x4*)(OLAT + (size_t)(b * 128 + row) * 128 + 8 * c8);
          LAS float* d = OLT + ((row >> 4) * 128 + 8 * c8) * 16 + (row & 15);
#pragma unroll
          for (int e = 0; e < 4; ++e) { d[(2 * e) * 16] = bflo(v[e]); d[(2 * e + 1) * 16] = bfhi(v[e]); } }
      __syncthreads();
      const int d = tid & 63, h = tid >> 6; float acc[16];
#pragma unroll
      for (int t = 0; t < 16; ++t) acc[t] = 0.f;
#pragma unroll 8
      for (int r = 0; r < 128; ++r) { const float w = w_uv[(size_t)(r * 8 + h) * 64 + d]; const LAS float* ol = OLT + (h * 128 + r) * 16;
#pragma unroll
          for (int t4 = 0; t4 < 4; ++t4) { const f32x4 x = *(const LAS f32x4*)(ol + 4 * t4); acc[4 * t4] += x.x * w; acc[4 * t4 + 1] += x.y * w; acc[4 * t4 + 2] += x.z * w; acc[4 * t4 + 3] += x.w * w; } }
#pragma unroll
      for (int t = 0; t < 16; ++t) MIXED[(size_t)(rowbase + t) * 1024 + h * 64 + d] = f2bf(acc[t]); }
    __syncthreads();
}
__device__ __forceinline__ void cross_sample_item(LAS unsigned char* lds, const bf16* QC, const float* mk, const float* mv, bf16* OC, int b, int hh) {
    LAS float* qc = (LAS float*)lds;
    LAS float* Pw = qc + 16 * 256;
    LAS float* KT = Pw + 8 * 512;
    const int tid_ = my_tid(lds); const int tid = tid_, lane = tid & 63; const int wid = __builtin_amdgcn_readfirstlane(tid >> 6);
    const int rowbase = MP + b * 16;
#pragma unroll
    for (int i = 0; i < 8; ++i) { const int idx = tid + 512 * i, t = idx >> 8, e = idx & 255; qc[idx] = bf2f(QC[(size_t)(rowbase + t) * 1024 + hh * 256 + e]); }
    const int t0 = 2 * wid; const LAS float* q0 = qc + t0 * 256; const LAS float* q1 = q0 + 256; LAS float* P = Pw + wid * 512;
    float s0[4], s1[4];
#pragma unroll 1
    for (int jt = 0; jt < 4; ++jt) {
        f32x4 st[8];
#pragma unroll
        for (int i = 0; i < 8; ++i) { const int ci = tid + 512 * i, key = ci >> 6, ch = ci & 63; st[i] = *(const f32x4*)(mk + ((size_t)(b * 256 + 64 * jt + key) * 4 + hh) * 256 + 4 * ch); }
        __syncthreads();
#pragma unroll
        for (int i = 0; i < 8; ++i) { const int ci = tid + 512 * i, key = ci >> 6, ch = ci & 63; *(LAS f32x4*)(KT + key * 260 + 4 * ch) = st[i]; }
        __syncthreads();
        const LAS float* kr = KT + lane * 260; float a0 = 0.f, a1 = 0.f;
#pragma unroll 8
        for (int i = 0; i < 64; ++i) { const f32x4 kv = *(const LAS f32x4*)(kr + 4 * i); const f32x4 a = *(const LAS f32x4*)(q0 + 4 * i), c = *(const LAS f32x4*)(q1 + 4 * i);
            a0 += (kv.x * a.x + kv.y * a.y) + (kv.z * a.z + kv.w * a.w); a1 += (kv.x * c.x + kv.y * c.y) + (kv.z * c.z + kv.w * c.w); }
        if (jt == 0) { s0[0] = a0; s1[0] = a1; } else if (jt == 1) { s0[1] = a0; s1[1] = a1; } else if (jt == 2) { s0[2] = a0; s1[2] = a1; } else { s0[3] = a0; s1[3] = a1; }
    }
    const float mx0 = wave_max(fmaxf(fmaxf(s0[0], s0[1]), fmaxf(s0[2], s0[3]))), mx1 = wave_max(fmaxf(fmaxf(s1[0], s1[1]), fmaxf(s1[2], s1[3])));
    float sm0 = 0.f, sm1 = 0.f;
#pragma unroll
    for (int j = 0; j < 4; ++j) { const float p0 = __builtin_amdgcn_exp2f(s0[j] - mx0), p1 = __builtin_amdgcn_exp2f(s1[j] - mx1); P[lane + 64 * j] = p0; P[256 + lane + 64 * j] = p1; sm0 += p0; sm1 += p1; }
    sm0 = wave_sum(sm0); sm1 = wave_sum(sm1);
    asm volatile("s_waitcnt lgkmcnt(0)" ::: "memory");
    f32x4 o0 = {0.f, 0.f, 0.f, 0.f}, o1 = {0.f, 0.f, 0.f, 0.f};
    const float* vbp = mv + ((size_t)(b * 256) * 4 + hh) * 256 + 4 * lane;
#pragma unroll 1
    for (int m0 = 0; m0 < 256; m0 += 16) { f32x4 vv[16];
#pragma unroll
        for (int i = 0; i < 16; ++i) vv[i] = *(const f32x4*)(vbp + (size_t)(m0 + i) * 1024);
#pragma unroll
        for (int i = 0; i < 16; ++i) { o0 += vv[i] * P[m0 + i]; o1 += vv[i] * P[256 + m0 + i]; } }
    const float i0 = 1.f / sm0, i1 = 1.f / sm1; o0 = o0 * i0; o1 = o1 * i1;
    u32x2 w0, w1; w0.x = pk2(o0.x, o0.y); w0.y = pk2(o0.z, o0.w); w1.x = pk2(o1.x, o1.y); w1.y = pk2(o1.z, o1.w);
    *(u32x2*)(OC + (size_t)(rowbase + t0) * 1024 + hh * 256 + 4 * lane) = w0; *(u32x2*)(OC + (size_t)(rowbase + t0 + 1) * 1024 + hh * 256 + 4 * lane) = w1;
    __syncthreads();
}
__device__ __forceinline__ void conv_act_item(LAS unsigned char* lds, const bf16* U, int grow0, int blk, const float* cw, const float* cb, const float* sbuf, bf16* ACT) {
    const int tid_ = my_tid(lds); const int tid = tid_; if (tid >= 352) return;
    const int f0 = 8 * tid, R0 = grow0 + 16 * blk, ac = 256 * (f0 >> 7) + (f0 & 127), gc = ac + 128;
    float w0a[8], w1a[8], w2a[8], ba[8], w0g[8], w1g[8], w2g[8], bg[8], a2[8], a1[8], g2[8], g1[8];
#pragma unroll
    for (int i = 0; i < 8; ++i) { w0a[i] = cw[f0 + i]; w1a[i] = cw[NUP + f0 + i]; w2a[i] = cw[2 * NUP + f0 + i]; ba[i] = cb[f0 + i];
        w0g[i] = cw[NFF + f0 + i]; w1g[i] = cw[NUP + NFF + f0 + i]; w2g[i] = cw[2 * NUP + NFF + f0 + i]; bg[i] = cb[NFF + f0 + i]; }
    if (R0 >= MP) { const float* sb = sbuf + (size_t)((R0 - MP) >> 4) * 2 * NUP;
#pragma unroll
        for (int i = 0; i < 8; ++i) { a2[i] = sb[f0 + i]; a1[i] = sb[NUP + f0 + i]; g2[i] = sb[NFF + f0 + i]; g1[i] = sb[NUP + NFF + f0 + i]; }
    } else if ((R0 & (SEQ - 1)) == 0) {
#pragma unroll
        for (int i = 0; i < 8; ++i) { a2[i] = 0.f; a1[i] = 0.f; g2[i] = 0.f; g1[i] = 0.f; }
    } else { const bf16* u2 = U + (size_t)(R0 - 2 - grow0) * NUP; const bf16* u1 = u2 + NUP;
        const u32x4 x2 = *(const u32x4*)(u2 + ac), y2 = *(const u32x4*)(u2 + gc), x1 = *(const u32x4*)(u1 + ac), y1 = *(const u32x4*)(u1 + gc);
#pragma unroll
        for (int e = 0; e < 4; ++e) { a2[2 * e] = bflo(x2[e]); a2[2 * e + 1] = bfhi(x2[e]); g2[2 * e] = bflo(y2[e]); g2[2 * e + 1] = bfhi(y2[e]);
            a1[2 * e] = bflo(x1[e]); a1[2 * e + 1] = bfhi(x1[e]); g1[2 * e] = bflo(y1[e]); g1[2 * e + 1] = bfhi(y1[e]); } }
    for (int t = 0; t < 16; ++t) { const bf16* u0 = U + (size_t)(R0 + t - grow0) * NUP; const u32x4 x0 = *(const u32x4*)(u0 + ac), y0 = *(const u32x4*)(u0 + gc);
        float a0[8], g0[8], r[8];
#pragma unroll
        for (int e = 0; e < 4; ++e) { a0[2 * e] = bflo(x0[e]); a0[2 * e + 1] = bfhi(x0[e]); g0[2 * e] = bflo(y0[e]); g0[2 * e + 1] = bfhi(y0[e]); }
#pragma unroll
        for (int i = 0; i < 8; ++i) { const float ca = ba[i] + w0a[i] * a2[i] + w1a[i] * a1[i] + w2a[i] * a0[i], cg = bg[i] + w0g[i] * g2[i] + w1g[i] * g1[i] + w2g[i] * g0[i];
            r[i] = silu(ca) * cg; a2[i] = a1[i]; a1[i] = a0[i]; g2[i] = g1[i]; g1[i] = g0[i]; }
        u32x4 w; w.x = pk2(r[0], r[1]); w.y = pk2(r[2], r[3]); w.z = pk2(r[4], r[5]); w.w = pk2(r[6], r[7]);
        *(u32x4*)(ACT + (size_t)(R0 + t) * NFF + f0) = w; }
}

__device__ __forceinline__ void conv_fix_item(LAS unsigned char* lds, const bf16* HB, int gi, const float* cw, const float* cb, bf16* ACT) {
    const int tid = my_tid(lds); if (tid >= 352) return;
    const int f0 = 8 * tid; const bool first = (gi & 255) == 0;
    const bf16* h = HB + (size_t)gi * 4 * NUP; const bf16* hp = HB + (size_t)(gi - 1) * 4 * NUP;
    float r0[8], r1[8];
#pragma unroll
    for (int part = 0; part < 2; ++part) { const int c0 = part * NFF + f0;
        const u32x4 u0 = *(const u32x4*)(h + c0), u1 = *(const u32x4*)(h + NUP + c0);
        u32x4 p2 = {0u, 0u, 0u, 0u}, p3 = {0u, 0u, 0u, 0u}; if (!first) { p2 = *(const u32x4*)(hp + 2 * NUP + c0); p3 = *(const u32x4*)(hp + 3 * NUP + c0); }
#pragma unroll
        for (int i = 0; i < 8; ++i) { const float w0 = cw[c0 + i], w1 = cw[NUP + c0 + i], w2 = cw[2 * NUP + c0 + i], bb = cb[c0 + i];
            const float x0 = (i & 1) ? bfhi(u0[i >> 1]) : bflo(u0[i >> 1]), x1 = (i & 1) ? bfhi(u1[i >> 1]) : bflo(u1[i >> 1]);
            const float q2 = (i & 1) ? bfhi(p2[i >> 1]) : bflo(p2[i >> 1]), q3 = (i & 1) ? bfhi(p3[i >> 1]) : bflo(p3[i >> 1]);
            const float c_0 = bb + w0 * q2 + w1 * q3 + w2 * x0, c_1 = bb + w0 * q3 + w1 * x0 + w2 * x1;
            if (part == 0) { r0[i] = silu(c_0); r1[i] = silu(c_1); } else { r0[i] *= c_0; r1[i] *= c_1; } } }
    u32x4 w; w.x = pk2(r0[0], r0[1]); w.y = pk2(r0[2], r0[3]); w.z = pk2(r0[4], r0[5]); w.w = pk2(r0[6], r0[7]); *(u32x4*)(ACT + (size_t)(64 * gi) * NFF + f0) = w;
    w.x = pk2(r1[0], r1[1]); w.y = pk2(r1[2], r1[3]); w.z = pk2(r1[4], r1[5]); w.w = pk2(r1[6], r1[7]); *(u32x4*)(ACT + (size_t)(64 * gi + 1) * NFF + f0) = w;
}
constexpr size_t MiB = 1u << 20;
constexpr size_t WS_CTL = 0;
constexpr size_t WS_WIN = 1 * MiB, WS_WUQ = 6 * MiB, WS_WUK = 6 * MiB + 512 * 1024, WS_WUV = 6 * MiB + 768 * 1024, WS_WO = 7 * MiB, WS_WCQ = 9 * MiB, WS_WCKV = 11 * MiB, WS_WCO = 15 * MiB,
                 WS_WUP = 17 * MiB, WS_WDN = 28 * MiB, WS_MN = 34 * MiB, WS_MK = 35 * MiB, WS_MVT = 36 * MiB;
constexpr size_t WS_H = 38 * MiB;
constexpr size_t WS_CQN = WS_H, WS_CKV = WS_H + 17 * MiB, WS_MIXED = WS_H;
constexpr size_t WS_Z = 104 * MiB;
constexpr size_t WS_KR = 267 * MiB, WS_Q = 269 * MiB, WS_KN = 318 * MiB, WS_VT = 350 * MiB, WS_AT = 382 * MiB, WS_END = 510 * MiB;
constexpr size_t WS_QC = 104 * MiB, WS_OC = 170 * MiB;
constexpr size_t WS_U = 104 * MiB, WS_HB = 104 * MiB, WS_US = 136 * MiB, WS_OCS = 286 * MiB, WS_QA = 287 * MiB, WS_OLAT = 288 * MiB + 512 * 1024, WS_ACT = 290 * MiB;
static_assert(WS_WUP + (size_t)NUP * 1024 * 2 <= WS_WDN && WS_WDN + (size_t)1024 * NFF * 2 <= WS_MN && WS_H + (size_t)MT * 1024 * 2 <= WS_Z && WS_Z + (size_t)MT * NZ * 2 <= WS_KR &&
              WS_Q + (size_t)MT * 768 * 2 <= WS_KN && WS_AT + (size_t)2 * 256 * 4 * 16384 * 4 <= WS_END && WS_U + (size_t)(16384 + 512) * NUP * 2 <= WS_ACT && WS_ACT + (size_t)MT * NFF * 2 <= WS_END &&
              WS_CQN + (size_t)MT * 256 * 2 <= WS_CKV && WS_OC + (size_t)MT * 1024 * 2 <= WS_KR, "ws map");
constexpr int LDS_BYTES = 155648;
#ifndef SUB
#define SUB 15
#endif
#ifndef PH
#define PH 0xfff
#endif


#define RLX_AGENT __ATOMIC_RELAXED, __HIP_MEMORY_SCOPE_AGENT
#define XB_TMO      128
#define XB_XCNT(j)  (256  + 64 * (j))
#define XB_XSUB(j)  (1280 + 64 * (j))
#define XB_XGEN(j)  (2304 + 64 * (j))
#define XB_TOP      3328
#define XB_TOPGEN   3392
#define XCD_BAR_WORDS 3456
#define XB_SPIN_CAP (1u << 22)
__device__ __forceinline__ unsigned xb_ld(unsigned* p)              { return __hip_atomic_load(p, __ATOMIC_RELAXED, __HIP_MEMORY_SCOPE_AGENT); }
__device__ __forceinline__ unsigned xb_add(unsigned* p, unsigned v) { return __hip_atomic_fetch_add(p, v, __ATOMIC_RELAXED, __HIP_MEMORY_SCOPE_AGENT); }
__device__ __forceinline__ unsigned xb_xcc_id() { return (unsigned)__builtin_amdgcn_s_getreg((3 << 11) | 20) & 0xFu; }
#define XB_SPIN(cond, bar) do { unsigned _sp = 0; while (cond) { __builtin_amdgcn_s_sleep(1); \
    if ((++_sp & 255u) == 0u) { if (xb_ld(&(bar)[XB_TMO])) break; if (_sp > XB_SPIN_CAP) { atomicAdd(&(bar)[XB_TMO], 1u); break; } } } } while (0)
struct XcdBarrier { unsigned* bar; unsigned x; volatile LAS unsigned* st; };
__device__ __forceinline__ XcdBarrier xcd_barrier_post(unsigned* bar, volatile LAS unsigned* st) {
    XcdBarrier b; b.bar = bar; b.x = xb_xcc_id(); b.st = st;
    if (threadIdx.x == 0) (void)xb_add(&bar[XB_XCNT(b.x)], 1u);
    return b;
}
__device__ __forceinline__ void xcd_barrier_complete(unsigned* bar, unsigned x, unsigned& nloc, unsigned& nx) {
    const unsigned G = gridDim.x * gridDim.y * gridDim.z;
    unsigned sum, cnt, mine, sp = 0u;
    for (;;) {
        sum = 0u; cnt = 0u; mine = 0u;
#pragma unroll
        for (unsigned j = 0; j < 16; ++j) { const unsigned c = xb_ld(&bar[XB_XCNT(j)]); sum += c; cnt += (c > 0u) ? 1u : 0u; mine = (j == x) ? c : mine; }
        if (sum == G) break;
        __builtin_amdgcn_s_sleep(1);
        if ((++sp & 255u) == 0u) { if (xb_ld(&bar[XB_TMO])) break; if (sp > XB_SPIN_CAP) { atomicAdd(&bar[XB_TMO], 1u); break; } }
    }
    nloc = mine > 0u ? mine : 1u; nx = cnt > 0u ? cnt : 1u;
}
__device__ __forceinline__ void xcd_barrier(const XcdBarrier& b, bool leader) {
    asm volatile("s_waitcnt vmcnt(0)" ::: "memory");
    __syncthreads();
    if (leader) {
        unsigned* bar = b.bar;
        __builtin_amdgcn_s_waitcnt(0);
        unsigned nloc = b.st[0], nx = b.st[1];
        if (nloc == 0u) { xcd_barrier_complete(bar, b.x, nloc, nx); b.st[0] = nloc; b.st[1] = nx; }
        const unsigned old = xb_add(&bar[XB_XSUB(b.x)], 1u);
        const unsigned gen = old / nloc;
        if (old + 1u == (gen + 1u) * nloc) {
            __builtin_amdgcn_fence(__ATOMIC_RELEASE, "agent");
            asm volatile("s_waitcnt vmcnt(0)" ::: "memory");
            const unsigned og = xb_add(&bar[XB_TOP], 1u);
            const unsigned tg = og / nx;
            if (og + 1u == (tg + 1u) * nx) xb_add(&bar[XB_TOPGEN], 1u);
            else XB_SPIN(xb_ld(&bar[XB_TOPGEN]) == tg, bar);
            __builtin_amdgcn_fence(__ATOMIC_ACQUIRE, "agent");
            xb_add(&bar[XB_XGEN(b.x)], 1u);
            asm volatile("s_waitcnt vmcnt(0)" ::: "memory");
        } else {
            XB_SPIN(xb_ld(&bar[XB_XGEN(b.x)]) == gen, bar);
            __builtin_amdgcn_fence(__ATOMIC_ACQUIRE, "agent");
            asm volatile("s_waitcnt vmcnt(0)" ::: "memory");
        }
    }
    __syncthreads();
}
constexpr size_t CTL_ZERO_BYTES = 65536;

struct Params { const float* in[30]; float* out; unsigned char* ws; };

#define GSYNC() do { XcdBarrier xb_; xb_.bar = (unsigned*)tab_get(lds, 31) + 1024; xb_.x = xb_xcc_id(); xb_.st = (volatile LAS unsigned*)(lds + TAB_OFF + 256); xcd_barrier(xb_, my_tid(lds) == 0); } while (0)
#define fresh_lane() (my_tid(lds) & 63)
#define LGS(a) float a[4]; _Pragma("unroll") for (int i_ = 0; i_ < 4; ++i_) a[i_] = log2f(1.0f - exp2f(-5.0f - (float)i_))

__global__ void __launch_bounds__(512, 2) mega_fwd(Params p) {
    extern __shared__ __attribute__((aligned(16))) unsigned char lds_raw[];
    LAS unsigned char* lds = (LAS unsigned char*)lds_raw;
    cg::grid_group grid = cg::this_grid();
    const int tid = threadIdx.x; const int wave = __builtin_amdgcn_readfirstlane(tid >> 6);
    const int G = gridDim.x, bx = blockIdx.x; const int vcu = (G % 8 == 0) ? (bx % 8) * (G / 8) + bx / 8 : bx;
    const int gw = vcu * 8 + wave, NGW = G * 8;
    { const unsigned hw = (unsigned)__builtin_amdgcn_s_getreg((5 << 11) | 4) & 63u; *(volatile LAS int*)(lds + TAB_OFF + 512 + 4 * hw) = tid >> 6; }
    if (tid == 0) { LAS unsigned long long* tab = (LAS unsigned long long*)(lds + TAB_OFF);
#pragma unroll
        for (int i = 0; i < 30; ++i) tab[i] = (unsigned long long)p.in[i];
        tab[30] = (unsigned long long)p.out; tab[31] = (unsigned long long)p.ws;
        ((volatile LAS unsigned*)(lds + TAB_OFF + 256))[0] = 0u; ((volatile LAS unsigned*)(lds + TAB_OFF + 256))[1] = 0u; }
    __syncthreads();
    (void)xcd_barrier_post((unsigned*)p.ws + 1024, (volatile LAS unsigned*)(lds + TAB_OFF + 256));

#define QNEXT(ctrw, dst) do { __syncthreads(); if (my_tid(lds) == 0) *(volatile LAS int*)(lds + TAB_OFF + 264) = (int)atomicAdd((unsigned*)tab_get(lds, 31) + 8192 + 64 * (ctrw), 1u); \
        __syncthreads(); dst = __builtin_amdgcn_readfirstlane(*(volatile LAS int*)(lds + TAB_OFF + 264)); } while (0)
#define SROWS (size_t)MP
    {
        const int lane = fresh_lane(); LAS float* scr = (LAS float*)(lds + wave * 16384);
        constexpr int I_IN = 16 * 77, I_UQ = 4 * 24, I_UK = 2 * 16, I_UV = 2 * 16, I_SQ = 16 * 32, I_UP = 16 * 176, I_DN = 44 * 32;
        constexpr int NITEMS = I_IN + I_UQ + I_UK + I_UV + 2 * I_SQ;
        for (int it = gw; it < NITEMS; it += NGW) {
            int r = it;
            if (r < I_IN) { p0_transpose_item(INP(10), 1024, ZC_END, WSB(WS_WIN), 1.f, 0, scr, r, lane); continue; } r -= I_IN;
            if (r < I_UQ) { p0_transpose_item(INP(13), 256, 768, WSB(WS_WUQ), 0.10206207261596577f * LOG2E, 0, scr, r, lane); continue; } r -= I_UQ;
            if (r < I_UK) { p0_transpose_item(INP(14), 128, 512, WSB(WS_WUK), 1.f, 0, scr, r, lane); continue; } r -= I_UK;
            if (r < I_UV) { p0_transpose_item(INP(15), 128, 512, WSB(WS_WUV), 1.f, 0, scr, r, lane); continue; } r -= I_UV;
            if (r < I_SQ) { p0_transpose_item(INP(21), 1024, 1024, WSB(WS_WCKV), 1.f, 0, scr, r, lane); continue; } r -= I_SQ;
            p0_transpose_item(INP(22), 1024, 1024, WSB(WS_WCKV), 1.f, 1024, scr, r, lane);
        }
        { const int t_ = my_tid(lds); bf16* WIN = WSB(WS_WIN); for (int i = bx * 512 + t_; i < 96 * 128; i += G * 512) ((u32x4*)(WIN + (size_t)ZC_END * 1024))[i] = (u32x4){0u, 0u, 0u, 0u}; }
        { const float* x_p = INP(0); const float* x_s = INP(1); const float* g = INP(9); bf16* H = WSB(WS_H);
          for (int m = gw; m < MP; m += 2 * NGW) { const int m1 = m + NGW;
              if (m1 < MP) rms_row2_to_bf16(x_p + (size_t)m * DM, x_p + (size_t)m1 * DM, g, H + (size_t)m * DM, H + (size_t)m1 * DM, lane); else rms_row_to_bf16(x_p + (size_t)m * DM, g, H + (size_t)m * DM, lane); }
          for (int m = gw; m < MS; m += NGW) rms_row_to_bf16(x_s + (size_t)m * DM, g, H + (size_t)(MP + m) * DM, lane); }
        { const float* mem_p = INP(8); const float* g = INP(19); bf16* MN = WSB(WS_MN);
          for (int m = gw; m < 512; m += NGW) rms_row_to_bf16(mem_p + (size_t)m * DM, g, MN + (size_t)m * DM, lane); }
    }
    if (gridDim.y > 1u) grid.sync();
    GSYNC();
    { pg8::Gemm g{WSB(WS_H), WSB(WS_WIN), MP, NZ, 1024, 1024, 1024}; pg8::StaticOrder S; S.init(MP, NZ, G, bx); pg8::EpiStoreBf16 E{WSB(WS_Z), NZ}; pg8::gemm_phase(lds, g, S, E); }
    GSYNC();
    {
        { pg8::Gemm g{WSB(WS_H) + SROWS * DM, WSB(WS_WIN), MS, NZ, 1024, 1024, 1024}; pg8::StaticOrder S; S.init(MS, NZ, G, bx); pg8::EpiStoreBf16 E{WSB(WS_Z) + SROWS * NZ, NZ}; pg8::gemm_phase(lds, g, S, E); }
        { pg8::Gemm g{WSB(WS_MN), WSB(WS_WCKV), 512, 2048, 1024, 1024, 1024}; pg8::StaticOrder S; S.init(512, 2048, G, (bx + G - 20) % G); pg8::EpiMemKV E{OUTP(), WSB(WS_MK)}; pg8::gemm_phase(lds, g, S, E); }
        { pg8::Gemm g{WSB(WS_WCKV) + (size_t)1024 * 1024, WSB(WS_MN), 1024, 512, 1024, 1024, 1024}; pg8::StaticOrder S; S.init(1024, 512, G, (bx + G - 36) % G); pg8::EpiStoreBf16 E{WSB(WS_MVT), 512}; pg8::gemm_phase(lds, g, S, E); }
        { const int lane = fresh_lane(); bf16 *Z = WSB(WS_Z), *CQN = WSB(WS_CQN), *CKV = WSB(WS_CKV), *KR = WSB(WS_KR); float* out = OUTP(); const float *qg = INP(11), *kvg = INP(12);
          for (;;) { int it; QNEXT(0, it); if (it >= MP / 64) break;
#pragma unroll 1
              for (int k = 0; k < 8; ++k) row_post(Z, CQN, CKV, KR, out, qg, kvg, it * 64 + wave * 8 + k, lane); } }
    }
    GSYNC();
    {
        { const int lane = fresh_lane(); bf16 *Z = WSB(WS_Z), *CQN = WSB(WS_CQN), *CKV = WSB(WS_CKV), *KR = WSB(WS_KR); float* out = OUTP(); const float *qg = INP(11), *kvg = INP(12);
          for (int m = gw; m < MS; m += NGW) row_post(Z, CQN, CKV, KR, out, qg, kvg, MP + m, lane); }
        { pg8::Gemm g{WSB(WS_CQN), WSB(WS_WUQ), MP, 768, 256, 256, 256}; pg8::StaticOrder S; S.init(MP, 768, G, bx); pg8::EpiStoreBf16 E{WSB(WS_Q), 768}; pg8::gemm_phase(lds, g, S, E); }
        { pg8::Gemm g{WSB(WS_CKV), WSB(WS_WUK), MP, 512, 128, 128, 128}; pg8::StaticOrder S; S.init(MP, 512, G, (bx + 128) % G); pg8::EpiStoreBf16 E{WSB(WS_KN), 512}; pg8::gemm_phase(lds, g, S, E); }
        { pg8::Gemm g{WSB(WS_WUV), WSB(WS_CKV), 512, MP, 128, 128, 128}; pg8::StaticOrder S; S.init(512, MP, G, (bx + 128) % G); pg8::EpiStoreBf16 E{WSB(WS_VT), MP}; pg8::gemm_phase(lds, g, S, E); }
        { LGS(lgs); const bf16* Z = WSB(WS_Z); bf16* AT = WSB(WS_AT);
          for (int it = vcu; it < 2 * 256 * 4; it += G) { const int hh = it & 3, c = (it >> 2) & 255, b = it >> 10; ret_kv_item(lds, Z, AT, b, c, hh, lgs[hh]); } }
    }
    GSYNC();
    {
        { pg8::Gemm g{WSB(WS_CQN) + SROWS * 256, WSB(WS_WUQ), MS, 768, 256, 256, 256}; pg8::StaticOrder S; S.init(MS, 768, G, bx); pg8::EpiStoreBf16 E{WSB(WS_Q) + SROWS * 768, 768}; pg8::gemm_phase(lds, g, S, E); }
        { LGS(lgs); ret_scan(lds, WSB(WS_AT), OUTP(), G, lgs); }
        { const bf16 *Q = WSB(WS_Q), *KN = WSB(WS_KN), *KR = WSB(WS_KR), *VT = WSB(WS_VT); bf16* MIXED = WSB(WS_MIXED);
          for (int pr = vcu; pr < 512; pr += G) { const int bh = pr >> 5, pi = pr & 31, b = bh >> 3, h = bh & 7; const size_t rb = (size_t)b * SEQ;
#pragma unroll 1
            for (int k = 0; k < 2; ++k) { const int qb = k == 0 ? 63 - pi : pi;
                flash_unit<96, 64, 0>(lds, Q + (rb + 256 * qb) * 768 + h * 96, 768, KN + rb * 512 + h * 64, 512, KR + rb * 32, VT + (size_t)(h * 64) * MP + rb, MP,
                                      MIXED + (rb + 256 * qb) * 1024 + h * 64, 1024, 4 * qb + 4, 4 * qb, 256 * qb); } } }
    }
    GSYNC();
    {
        constexpr int J_SQ = 16 * 32, J_UP = 16 * 176, J_DN = 44 * 32, NWT = (3 * J_SQ + J_UP + J_DN) / 8;
        for (;;) { int it; QNEXT(5, it); if (it >= 32 + 512 + 128 + NWT) break;
            if (it < 32) mla_sample_unit(lds, WS_Q, WS_OLAT, WS_MIXED, it);
            else if (it < 32 + 512) { LGS(lgs); const int i2 = it - 32; ret_out_item(lds, WSB(WS_Z), WSB(WS_AT), INP(16), WSB(WS_MIXED), i2 >> 8, i2 & 255, lgs); }
            else if (it < 32 + 512 + 128) { LGS(lgs); const int i3 = it - 32 - 512, hh = i3 & 3; ret_sample_item(lds, WSB(WS_Z), INP(4), INP(16), OUTP(), WSB(WS_MIXED), i3 >> 2, hh, lgs[hh]); }
            else { const int lane = fresh_lane(); LAS float* scr = (LAS float*)(lds + wave * 16384); int r = (it - 32 - 512 - 128) * 8 + wave;
                if (r < J_SQ) p0_transpose_item(INP(17), 1024, 1024, WSB(WS_WO), 1.f, 0, scr, r, lane);
                else if ((r -= J_SQ) < J_SQ) p0_transpose_item(INP(20), 1024, 1024, WSB(WS_WCQ), 0.0625f * LOG2E, 0, scr, r, lane);
                else if ((r -= J_SQ) < J_SQ) p0_transpose_item(INP(23), 1024, 1024, WSB(WS_WCO), 1.f, 0, scr, r, lane);
                else if ((r -= J_SQ) < J_UP) p0_transpose_item(INP(25), 1024, NUP, WSB(WS_WUP), 1.f, 0, scr, r, lane, 1);
                else { r -= J_UP; p0_transpose_item(INP(28), NFF, 1024, WSB(WS_WDN), 1.f, 0, scr, r, lane); } } }
    }
    GSYNC();
    { pg8::Gemm g{WSB(WS_MIXED), WSB(WS_WO), MP, 1024, 1024, 1024, 1024}; pg8::StaticOrder S; S.init(MP, 1024, G, bx); pg8::EpiResid E{INP(0), OUTP()}; pg8::gemm_phase(lds, g, S, E); }
    GSYNC();
    {
        { pg8::Gemm g{WSB(WS_MIXED) + SROWS * DM, WSB(WS_WO), MS, 1024, 1024, 1024, 1024}; pg8::StaticOrder S; S.init(MS, 1024, G, bx); pg8::EpiResid E{INP(1), OUTP() + SROWS * DM}; pg8::gemm_phase(lds, g, S, E); }
        { const int lane = fresh_lane(); const float* X = OUTP(); const float* g = INP(18); bf16* H = WSB(WS_H);
          for (;;) { int it; QNEXT(1, it); if (it >= MP / 64) break;
#pragma unroll 1
              for (int k = 0; k < 8; k += 2) { const int m = it * 64 + wave * 8 + k; rms_row2_to_bf16(X + (size_t)m * DM, X + (size_t)(m + 1) * DM, g, H + (size_t)m * DM, H + (size_t)(m + 1) * DM, lane); } } }
    }
    GSYNC();
    {
        { pg8::Gemm g{WSB(WS_H), WSB(WS_WCQ), MP, 1024, 1024, 1024, 1024}; pg8::StaticOrder S; S.init(MP, 1024, G, bx); pg8::EpiStoreBf16 E{WSB(WS_QC), 1024}; pg8::gemm_phase(lds, g, S, E); }
        { const int lane = fresh_lane(); const float* X = OUTP(); const float* g = INP(18); bf16* H = WSB(WS_H);
          for (int m = MP + gw; m < MT; m += NGW) rms_row_to_bf16(X + (size_t)m * DM, g, H + (size_t)m * DM, lane); }
    }
    GSYNC();
    {
        { pg8::Gemm g{WSB(WS_H) + SROWS * DM, WSB(WS_WCQ), MS, 1024, 1024, 1024, 1024}; pg8::StaticOrder S; S.init(MS, 1024, G, bx); pg8::EpiStoreBf16 E{WSB(WS_QC) + SROWS * DM, 1024}; pg8::gemm_phase(lds, g, S, E); }
        { const bf16 *QC = WSB(WS_QC), *MK = WSB(WS_MK), *MVT = WSB(WS_MVT); bf16* OC = WSB(WS_OC);
          for (;;) { int it; QNEXT(2, it); if (it >= 512) break;
              const int bh = it >> 6, qb = it & 63, b = bh >> 2, hh = bh & 3; const size_t rb = (size_t)b * SEQ + 256 * qb;
              flash_unit<256, 256, 1>(lds, QC + rb * 1024 + hh * 256, 1024, MK + (size_t)(b * 256) * 1024 + hh * 256, 1024, nullptr, MVT + (size_t)(hh * 256) * 512 + b * 256, 512,
                                      OC + rb * 1024 + hh * 256, 1024, 4, 1000, 0); } }
    }
    GSYNC();
    { float* X = OUTP(); pg8::Gemm g{WSB(WS_OC), WSB(WS_WCO), MP, 1024, 1024, 1024, 1024}; pg8::StaticOrder S; S.init(MP, 1024, G, bx); pg8::EpiResid E{X, X}; pg8::gemm_phase(lds, g, S, E); }
    GSYNC();
    {
        const int lane = fresh_lane(); const bf16* QC = WSB(WS_QC); bf16* OC = WSB(WS_OCS) - SROWS * DM; const float *c_mk = INP(6), *c_mv = INP(7); const float* X = OUTP(); const float* g = INP(24); bf16* H = WSB(WS_H);
        for (;;) { int it; QNEXT(3, it); if (it >= 128 + MP / 64) break;
            if (it < 128) cross_sample_item(lds, QC, c_mk, c_mv, OC, it >> 2, it & 3);
            else {
#pragma unroll 1
                for (int k = 0; k < 8; k += 2) { const int m = (it - 128) * 64 + wave * 8 + k; rms_row2_to_bf16(X + (size_t)m * DM, X + (size_t)(m + 1) * DM, g, H + (size_t)m * DM, H + (size_t)(m + 1) * DM, lane); } } }
    }
    GSYNC();
    { pg8::Gemm g{WSB(WS_H), WSB(WS_WUP), MP, NUP, 1024, 1024, 1024}; pg8::StaticOrder S; S.init(MP, NUP, G, bx); pg8::EpiUpConv E{WSB(WS_ACT), WSB(WS_HB), OUTP(), INP(26), INP(27), lds}; pg8::gemm_phase(lds, g, S, E); }
    GSYNC();
    {
#pragma unroll 1
        for (int pc = 0; pc < 4; ++pc) { pg8::Gemm g{WSB(WS_OCS) + 256 * pc, WSB(WS_WCO) + 256 * pc, MS, 1024, 256, 1024, 1024}; pg8::StaticOrder S; S.init(MS, 1024, G, (bx + G - 8 * pc) % G); pg8::EpiAtomicAdd E{OUTP() + SROWS * DM}; pg8::gemm_phase(lds, g, S, E); }
        { const bf16* HB = WSB(WS_HB); bf16* ACT = WSB(WS_ACT); const float *cw = INP(26), *cb = INP(27);
          for (;;) { int it; QNEXT(6, it); if (it >= MP / 64 / 4) break;
#pragma unroll 1
              for (int k = 0; k < 4; ++k) conv_fix_item(lds, HB, it * 4 + k, cw, cb, ACT); } }
    }
    GSYNC();
    {
        { const int lane = fresh_lane(); const float* X = OUTP(); const float* g = INP(24); bf16* H = WSB(WS_H);
          for (int m = MP + gw; m < MT; m += NGW) rms_row_to_bf16(X + (size_t)m * DM, g, H + (size_t)m * DM, lane); }
        { float* X = OUTP(); pg8::Gemm g{WSB(WS_ACT), WSB(WS_WDN), MP, 1024, NFF, NFF, NFF}; pg8::StaticOrder S; S.init(MP, 1024, G, bx); pg8::EpiResid E{X, X}; pg8::gemm_phase(lds, g, S, E); }
    }
    GSYNC();
    {
        { pg8::Gemm g{WSB(WS_H) + SROWS * DM, WSB(WS_WUP), MS, NUP, 1024, 1024, 1024}; pg8::StaticOrder S; S.init(MS, NUP, G, bx); pg8::EpiUpConvS E{WSB(WS_ACT) + SROWS * NFF, OUTP(), INP(26), INP(27), INP(5), lds}; pg8::gemm_phase(lds, g, S, E); }
        { const int lane = fresh_lane(); float* X = OUTP(); const float* g = INP(29);
          for (;;) { int it; QNEXT(4, it); if (it >= MP / 64) break;
#pragma unroll 1
              for (int k = 0; k < 8; ++k) rms_row_f32_inplace(X + (size_t)(it * 64 + wave * 8 + k) * DM, g, lane); } }
    }
    GSYNC();
    {
#pragma unroll 1
        for (int pc = 0; pc < 4; ++pc) { const int k0 = pc < 2 ? 768 * pc : 1536 + 640 * (pc - 2), kl = pc < 2 ? 768 : 640;
            pg8::Gemm g{WSB(WS_ACT) + SROWS * NFF + k0, WSB(WS_WDN) + k0, MS, 1024, kl, NFF, NFF}; pg8::StaticOrder S; S.init(MS, 1024, G, (bx + G - 8 * pc) % G); pg8::EpiAtomicAdd E{OUTP() + SROWS * DM}; pg8::gemm_phase(lds, g, S, E); }
    }
    GSYNC();
    { const int lane = fresh_lane(); float* X = OUTP(); const float* g = INP(29); for (int m = MP + gw; m < MT; m += NGW) rms_row_f32_inplace(X + (size_t)m * DM, g, lane); }
}

extern "C" void kernel_launch(void* const* d_in, const int* in_sizes, int n_in, void* d_out, int out_size, void* d_ws, size_t ws_size, hipStream_t stream) {
    static int grid = 0;
    if (grid == 0) {
        if (n_in != 30 || (size_t)out_size != O_END || ws_size < WS_END) { fprintf(stderr, "kernel_launch: unexpected problem (n_in %d, out %d, ws %zu)\n", n_in, out_size, ws_size); grid = -1; return; }
        int dev = 0, cus = 0, per_cu = 0;
        (void)hipGetDevice(&dev); (void)hipDeviceGetAttribute(&cus, hipDeviceAttributeMultiprocessorCount, dev);
        if (hipFuncSetAttribute((const void*)mega_fwd, hipFuncAttributeMaxDynamicSharedMemorySize, LDS_BYTES) != hipSuccess) { fprintf(stderr, "kernel_launch: hipFuncSetAttribute failed\n"); grid = -1; return; }
        if (hipOccupancyMaxActiveBlocksPerMultiprocessor(&per_cu, (const void*)mega_fwd, 512, LDS_BYTES) != hipSuccess || per_cu < 1) { fprintf(stderr, "kernel_launch: occupancy query says %d\n", per_cu); per_cu = 1; }
        (void)hipGetLastError();
        grid = cus;
    }
    if (grid < 0) return;
    if (hipMemsetAsync(d_ws, 0, CTL_ZERO_BYTES, stream) != hipSuccess) { fprintf(stderr, "kernel_launch: memset failed\n"); return; }
    Params p{};
    for (int i = 0; i < 30; ++i) p.in[i] = (const float*)d_in[i];
    p.out = (float*)d_out; p.ws = (unsigned char*)d_ws;
    void* args[] = {&p};
    hipError_t e = hipLaunchCooperativeKernel((const void*)mega_fwd, dim3(grid), dim3(512), args, LDS_BYTES, stream);
    if (e != hipSuccess) fprintf(stderr, "kernel_launch: cooperative launch failed: %s (grid %d)\n", hipGetErrorString(e), grid);
}
```

```cpp
#include <hip/hip_runtime.h>
#include <hip/hip_cooperative_groups.h>
#include <cstdio>
#include <cstdint>
namespace cg = cooperative_groups;

#define LAS __attribute__((address_space(3)))
typedef unsigned short bf16;
typedef short bf16x8 __attribute__((ext_vector_type(8)));
typedef float f32x2 __attribute__((ext_vector_type(2)));
typedef float f32x4 __attribute__((ext_vector_type(4)));
typedef float f32x16 __attribute__((ext_vector_type(16)));
typedef unsigned u32x2 __attribute__((ext_vector_type(2)));
typedef unsigned u32x4 __attribute__((ext_vector_type(4)));

constexpr int MP = 32768, MS = 512, MT = MP + MS, DM = 1024, SEQ = 16384, PAST = 2048;
constexpr int NZ = 2560;
constexpr int ZC_CKV = 256, ZC_KR = 384, ZC_RQ = 416, ZC_RK = 928, ZC_RV = 1440, ZC_RG = 1952, ZC_END = 2464;
constexpr int NFF = 2816, NUP = 5632;
constexpr float EPS = 1e-6f;
constexpr float LG2_10000 = 13.287712379549449f;
constexpr float LOG2E = 1.4426950408889634f;
constexpr size_t O_Y = 0;
constexpr size_t O_PCKV = (size_t)MT * DM;
constexpr size_t O_PKR = O_PCKV + (size_t)MP * 128;
constexpr size_t O_PRET = O_PKR + (size_t)MP * 32;
constexpr size_t O_PCONV = O_PRET + 2 * 4 * 128 * 128;
constexpr size_t O_PMK = O_PCONV + 2 * 2 * NUP;
constexpr size_t O_PMV = O_PMK + 2 * 256 * 1024;
constexpr size_t O_SCKV = O_PMV + 2 * 256 * 1024;
constexpr size_t O_SKR = O_SCKV + (size_t)MS * 128;
constexpr size_t O_SRET = O_SKR + (size_t)MS * 32;
constexpr size_t O_SCONV = O_SRET + 32 * 4 * 128 * 128;
constexpr size_t O_END = O_SCONV + 32 * 2 * NUP;
static_assert(O_END == 43063296, "output size");

__device__ __forceinline__ float bf2f(unsigned b) { return __uint_as_float(b << 16); }
__device__ __forceinline__ float bflo(unsigned w) { return __uint_as_float(w << 16); }
__device__ __forceinline__ float bfhi(unsigned w) { return __uint_as_float(w & 0xffff0000u); }
typedef __bf16 bf16x2_t __attribute__((ext_vector_type(2)));
__device__ __forceinline__ unsigned pk2(float lo, float hi) { const f32x2 v = {lo, hi}; return __builtin_bit_cast(unsigned, __builtin_convertvector(v, bf16x2_t)); }
__device__ __forceinline__ bf16 f2bf(float f) { return (bf16)(pk2(f, 0.f) & 0xffffu); }
template <int K> __device__ __forceinline__ float swz_xor(float v) { return __int_as_float(__builtin_amdgcn_ds_swizzle(__float_as_int(v), (K << 10) | 0x1f)); }
__device__ __forceinline__ float half_sum(float v) { auto rr = __builtin_amdgcn_permlane32_swap(__float_as_uint(v), __float_as_uint(v), false, false); return __uint_as_float(rr[0]) + __uint_as_float(rr[1]); }
__device__ __forceinline__ float half_max(float v) { auto rr = __builtin_amdgcn_permlane32_swap(__float_as_uint(v), __float_as_uint(v), false, false); return fmaxf(__uint_as_float(rr[0]), __uint_as_float(rr[1])); }
__device__ __forceinline__ float wave_sum(float v) { v += swz_xor<1>(v); v += swz_xor<2>(v); v += swz_xor<4>(v); v += swz_xor<8>(v); v += swz_xor<16>(v); return half_sum(v); }
__device__ __forceinline__ float wave_max(float v) { v = fmaxf(v, swz_xor<1>(v)); v = fmaxf(v, swz_xor<2>(v)); v = fmaxf(v, swz_xor<4>(v)); v = fmaxf(v, swz_xor<8>(v)); v = fmaxf(v, swz_xor<16>(v)); return half_max(v); }
__device__ __forceinline__ int crow(int r, int hi) { return (r & 3) + 8 * (r >> 2) + 4 * hi; }
__device__ __forceinline__ int row_pos(int r) { return r < MP ? (r & (SEQ - 1)) : PAST + ((r - MP) & 15); }
__device__ __forceinline__ void sincos_rev(float ang, float& s, float& c) {
    float rev = ang * 0.15915494309189535f; rev = rev - floorf(rev);
    s = __builtin_amdgcn_sinf(rev); c = __builtin_amdgcn_cosf(rev);
}
__device__ __forceinline__ float ex2f(float x) { return __builtin_amdgcn_exp2f(x); }
__device__ __forceinline__ float silu(float x) { return x * __builtin_amdgcn_rcpf(1.f + __builtin_amdgcn_exp2f(-1.4426950408889634f * x)); }

constexpr int TAB_OFF = 153600;
__device__ __forceinline__ int my_tid(LAS unsigned char* lds) {
    const unsigned hw = (unsigned)__builtin_amdgcn_s_getreg((5 << 11) | 4) & 63u;
    const int wv = __builtin_amdgcn_readfirstlane(*(volatile LAS int*)(lds + TAB_OFF + 512 + 4 * hw));
    int ln; asm volatile("v_mbcnt_lo_u32_b32 %0, -1, 0\n\tv_mbcnt_hi_u32_b32 %0, -1, %0" : "=v"(ln));
    return wv * 64 + ln;
}
__device__ __forceinline__ unsigned long long tab_get(LAS unsigned char* lds, int i) {
    const unsigned long long v = ((const volatile LAS unsigned long long*)(lds + TAB_OFF))[i];
    const unsigned lo = __builtin_amdgcn_readfirstlane((unsigned)v), hi = __builtin_amdgcn_readfirstlane((unsigned)(v >> 32));
    return ((unsigned long long)hi << 32) | lo;
}
#define INP(i) ((const float*)tab_get(lds, (i)))
#define OUTP() ((float*)tab_get(lds, 30))
#define WSB(off) ((bf16*)((unsigned char*)tab_get(lds, 31) + (off)))
#define WSF(off) ((float*)((unsigned char*)tab_get(lds, 31) + (off)))
#define MFMA32(a, b, c) __builtin_amdgcn_mfma_f32_32x32x16_bf16((a), (b), (c), 0, 0, 0)

namespace pg8 {
#define PG8_LAS __attribute__((address_space(3)))
typedef unsigned short bf16_t;
constexpr int BM = 256, BK = 64, HALF = 128, HTB = HALF * BK * 2, STAGE_BYTES = 8 * HTB, NXCD = 8, WGM = 8;
__host__ __device__ __forceinline__ int lds_byte(int r, int c) { const int st = (r >> 4) * 2 + (c >> 5), rr = r & 15, cc = c & 31, ob = rr * 64 + cc * 2; return st * 1024 + (ob ^ (((ob >> 9) & 1) << 5)); }
__host__ __device__ __forceinline__ void stage_rc(int b, int& R, int& C) { const int st = b / 1024, sb = b % 1024, swz = sb ^ (((sb >> 9) & 1) << 5); R = (st >> 1) * 16 + swz / 64; C = (st & 1) * 32 + (swz % 64) / 2; }
__host__ __device__ __forceinline__ int perm32(int rho) { const int n = rho >> 4, i = rho & 15; return 8 * (i >> 2) + 4 * n + (i & 3); }

struct Unit { int pm, pn; };
struct Gemm { const bf16_t* A; const bf16_t* Bt; int M, N, K, lda, ldb; };

struct StaticOrder {
    int nM, nN, nwg, G, c;
    __host__ __device__ void init(int M, int N, int G_, int c_) { nM = M / BM; nN = N / BM; nwg = nM * nN; G = G_; c = c_; }
    __host__ __device__ bool next(int i, Unit& u) const {
        const long L = (long)i * G + c; if (L >= nwg) return false;
        int wgid = (int)L; { const int q = nwg / NXCD, r = nwg % NXCD, xcd = wgid % NXCD, off = wgid / NXCD; wgid = (xcd < r ? xcd * (q + 1) : r * (q + 1) + (xcd - r) * q) + off; }
        const int nig = WGM * nN, gid = wgid / nig, fm = gid * WGM, gsz = (nM - fm) < WGM ? (nM - fm) : WGM;
        u.pm = fm + ((wgid % nig) % gsz); u.pn = (wgid % nig) / gsz; return true;
    }
};

template <class Epi, class Sched, bool ALIGN_EPI = true, bool SP2 = true>
__device__ __forceinline__ void gemm_phase(PG8_LAS unsigned char* lds, const Gemm g, const Sched& S, const Epi& E) {
    const int tid_ = my_tid(lds);
    const int tid = tid_, wid = __builtin_amdgcn_readfirstlane(tid >> 6), lane = tid & 63, wr = wid >> 2, wc = wid & 3, fr = lane & 15, fq = lane >> 4;
    const int K = g.K, nt = K / BK;
    unsigned voffA[2], voffB[2];
#pragma unroll
    for (int i = 0; i < 2; ++i) { int R, C; stage_rc(tid * 16 + i * 8192, R, C); const int Rb = ((R & ~31) + perm32(R & 31));
        voffA[i] = (unsigned)(R * g.lda + C) * 2u; voffB[i] = (unsigned)(Rb * g.ldb + C) * 2u; }
    const size_t kstep = (size_t)(BK * 2);
    const size_t hstepA = (size_t)HALF * g.lda * 2, hstepB = (size_t)HALF * g.ldb * 2;
    const size_t tstepA = 2 * hstepA, tstepB = 2 * hstepB;
    const unsigned ldsw = (unsigned)wid * 1024u;
    const int aoff = lds_byte(wr * 64 + fr, fq * 8), boff = lds_byte(wc * 32 + fr, fq * 8);
#define PG8_SA(b, h) (((b) * 2 + (h)) * HTB)
#define PG8_SB(b, h) ((4 + (b) * 2 + (h)) * HTB)
#define PG8_STAGE(bufoff, gbase, voff) do { _Pragma("unroll") for (int _i = 0; _i < 2; ++_i) \
        __builtin_amdgcn_global_load_lds((const unsigned*)((const char*)(gbase) + (voff)[_i]), (PG8_LAS unsigned*)(lds + (bufoff) + ldsw + _i * 8192), 16, 0, 0); } while (0)
#define PG8_LDA(dst, b, h) do { _Pragma("unroll") for (int m = 0; m < 4; ++m) _Pragma("unroll") for (int k = 0; k < 2; ++k) dst[m][k] = *(const PG8_LAS bf16x8*)(lds + PG8_SA(b, h) + aoff + m * 2048 + k * 1024); } while (0)
#define PG8_LDB(dst, b, h) do { _Pragma("unroll") for (int n = 0; n < 2; ++n) _Pragma("unroll") for (int k = 0; k < 2; ++k) dst[n][k] = *(const PG8_LAS bf16x8*)(lds + PG8_SB(b, h) + boff + n * 2048 + k * 1024); } while (0)
#define PG8_MMA(ai, bj, At, Bt) do { __builtin_amdgcn_s_setprio(1); _Pragma("unroll") for (int m = 0; m < 4; ++m) _Pragma("unroll") for (int n = 0; n < 2; ++n) _Pragma("unroll") for (int k = 0; k < 2; ++k) \
        acc[ai][bj][m][n] = __builtin_amdgcn_mfma_f32_16x16x32_bf16(Bt[n][k], At[m][k], acc[ai][bj][m][n], 0, 0, 0); __builtin_amdgcn_s_setprio(0); } while (0)
#define PG8_WAIT_V(n) asm volatile("s_waitcnt vmcnt(" #n ")" ::: "memory")
#define PG8_WAIT_L(n) asm volatile("s_waitcnt lgkmcnt(" #n ")" ::: "memory")
#define PG8_BAR __builtin_amdgcn_s_barrier()
#define PG8_SCHED __builtin_amdgcn_sched_barrier(0)
    Unit cur, nxt; int ui = 0;
    if (!S.next(0, cur)) return;
    f32x4 acc[2][2][4][2];
#pragma unroll
    for (int a = 0; a < 2; ++a)
#pragma unroll
        for (int b = 0; b < 2; ++b)
#pragma unroll
            for (int m = 0; m < 4; ++m)
#pragma unroll
                for (int n = 0; n < 2; ++n) acc[a][b][m][n] = (f32x4){0.f, 0.f, 0.f, 0.f};
    bf16x8 At[4][2], B0[2][2], B1[2][2];
    const char* cA = (const char*)g.A + (size_t)cur.pm * tstepA; const char* cB = (const char*)g.Bt + (size_t)cur.pn * tstepB;
    static_assert(SP2, "only the SP2 loop is carried here");
    PG8_STAGE(PG8_SB(0, 0), cB, voffB); PG8_STAGE(PG8_SB(0, 1), cB + hstepB, voffB); PG8_STAGE(PG8_SA(0, 0), cA, voffA); PG8_STAGE(PG8_SA(0, 1), cA + hstepA, voffA);
    if (wr == 1) PG8_BAR;
    PG8_WAIT_V(2); PG8_BAR;
    PG8_STAGE(PG8_SB(1, 0), cB + kstep, voffB); PG8_STAGE(PG8_SA(1, 0), cA + kstep, voffA); PG8_STAGE(PG8_SB(1, 1), cB + hstepB + kstep, voffB);
    PG8_WAIT_V(6); PG8_BAR;
    for (;;) {
        const bool has_next = S.next(ui + 1, nxt);
        const char* nA = has_next ? (const char*)g.A + (size_t)nxt.pm * tstepA : cA; const char* nB = has_next ? (const char*)g.Bt + (size_t)nxt.pn * tstepB : cB;
        for (int t = 0; t < nt; t += 2) {
            const bool last = (t == nt - 2);
            const char* a1 = cA + (size_t)(t + 1) * kstep;
            const char* a2 = last ? nA : cA + (size_t)(t + 2) * kstep; const char* b2 = last ? nB : cB + (size_t)(t + 2) * kstep;
            const char* a3 = a2 + kstep; const char* b3 = b2 + kstep;
            PG8_LDB(B0, 0, 0); PG8_LDB(B1, 0, 1); PG8_SCHED; PG8_LDA(At, 0, 0); PG8_STAGE(PG8_SA(1, 1), a1 + hstepA, voffA);
            PG8_WAIT_V(8); PG8_WAIT_L(0); PG8_BAR; PG8_MMA(0, 0, At, B0); PG8_MMA(0, 1, At, B1); PG8_BAR; PG8_SCHED;
            PG8_LDA(At, 0, 1); PG8_STAGE(PG8_SB(0, 0), b2, voffB); PG8_STAGE(PG8_SB(0, 1), b2 + hstepB, voffB); PG8_STAGE(PG8_SA(0, 0), a2, voffA);
            PG8_WAIT_V(8); PG8_WAIT_L(0); PG8_BAR; PG8_MMA(1, 0, At, B0); PG8_MMA(1, 1, At, B1); PG8_BAR; PG8_SCHED;
            PG8_LDB(B0, 1, 0); PG8_LDB(B1, 1, 1); PG8_SCHED; PG8_LDA(At, 1, 0); PG8_STAGE(PG8_SA(0, 1), a2 + hstepA, voffA);
            PG8_WAIT_V(8); PG8_WAIT_L(0); PG8_BAR; PG8_MMA(0, 0, At, B0); PG8_MMA(0, 1, At, B1); PG8_BAR; PG8_SCHED;
            PG8_LDA(At, 1, 1); PG8_STAGE(PG8_SB(1, 0), b3, voffB); PG8_STAGE(PG8_SB(1, 1), b3 + hstepB, voffB); PG8_STAGE(PG8_SA(1, 0), a3, voffA);
            PG8_WAIT_V(8); PG8_WAIT_L(0); PG8_BAR; PG8_MMA(1, 0, At, B0); PG8_MMA(1, 1, At, B1); PG8_BAR; PG8_SCHED;
        }
        if constexpr (ALIGN_EPI) { if (wr == 0) PG8_BAR; }
        E(acc, cur, wr, wc, fr, fq);
        if (!has_next) break;
#pragma unroll
        for (int a = 0; a < 2; ++a)
#pragma unroll
            for (int b = 0; b < 2; ++b)
#pragma unroll
                for (int m = 0; m < 4; ++m)
#pragma unroll
                    for (int n = 0; n < 2; ++n) acc[a][b][m][n] = (f32x4){0.f, 0.f, 0.f, 0.f};
        cur = nxt; cA = nA; cB = nB; ++ui;
        if constexpr (ALIGN_EPI) { if (wr == 1) PG8_BAR; }
    }
    PG8_WAIT_V(0);
    if constexpr (!ALIGN_EPI) { if (wr == 0) PG8_BAR; }
    PG8_BAR;
#undef PG8_SA
#undef PG8_SB
#undef PG8_STAGE
#undef PG8_LDA
#undef PG8_LDB
#undef PG8_MMA
#undef PG8_WAIT_V
#undef PG8_WAIT_L
#undef PG8_BAR
#undef PG8_SCHED
}
}
namespace pg8 {
#define EPI_ARGS f32x4 (&acc)[2][2][4][2], const Unit& u, int wr, int wc, int fr, int fq
struct EpiStoreBf16 {
    bf16* O; int ldc;
    __device__ __forceinline__ void operator()(EPI_ARGS) const {
        const int row0 = u.pm * BM + wr * 64 + fr, col0 = u.pn * BM + wc * 32 + 8 * fq;
#pragma unroll
        for (int ai = 0; ai < 2; ++ai)
#pragma unroll
            for (int m = 0; m < 4; ++m) { bf16* rowp = O + (size_t)(row0 + ai * HALF + m * 16) * ldc + col0;
#pragma unroll
                for (int bj = 0; bj < 2; ++bj) { const f32x4 v0 = acc[ai][bj][m][0], v1 = acc[ai][bj][m][1];
                    u32x4 w; w.x = pk2(v0[0], v0[1]); w.y = pk2(v0[2], v0[3]); w.z = pk2(v1[0], v1[1]); w.w = pk2(v1[2], v1[3]);
                    *(u32x4*)(rowp + bj * HALF) = w; } }
    }
};
struct EpiMemKV {
    float* out; bf16* MK;
    __device__ __forceinline__ void operator()(EPI_ARGS) const {
        const int row0 = u.pm * BM + wr * 64 + fr;
#pragma unroll
        for (int ai = 0; ai < 2; ++ai)
#pragma unroll
            for (int m = 0; m < 4; ++m) { const int row = row0 + ai * HALF + m * 16;
#pragma unroll
                for (int bj = 0; bj < 2; ++bj) { const int col = u.pn * BM + bj * HALF + wc * 32 + 8 * fq; const f32x4 v0 = acc[ai][bj][m][0], v1 = acc[ai][bj][m][1];
                    if (col < 1024) { float* o = out + O_PMK + (size_t)row * 1024 + col; *(f32x4*)o = v0; *(f32x4*)(o + 4) = v1;
                        u32x4 w; w.x = pk2(v0[0], v0[1]); w.y = pk2(v0[2], v0[3]); w.z = pk2(v1[0], v1[1]); w.w = pk2(v1[2], v1[3]);
                        *(u32x4*)(MK + (size_t)row * 1024 + col) = w;
                    } else { float* o = out + O_PMV + (size_t)row * 1024 + (col - 1024); *(f32x4*)o = v0; *(f32x4*)(o + 4) = v1; } } }
    }
};
struct EpiResid {
    const float* base; float* X;
    __device__ __forceinline__ void operator()(EPI_ARGS) const {
        const int row0 = u.pm * BM + wr * 64 + fr, col0 = u.pn * BM + wc * 32 + 8 * fq;
#pragma unroll
        for (int ai = 0; ai < 2; ++ai)
#pragma unroll
            for (int m = 0; m < 4; ++m) { const int row = row0 + ai * HALF + m * 16;
                const float* b = base + (size_t)row * DM + col0; float* o = X + (size_t)row * DM + col0;
#pragma unroll
                for (int bj = 0; bj < 2; ++bj) { const f32x4 b0 = *(const f32x4*)(b + bj * HALF), b1 = *(const f32x4*)(b + bj * HALF + 4);
                    *(f32x4*)(o + bj * HALF) = b0 + acc[ai][bj][m][0]; *(f32x4*)(o + bj * HALF + 4) = b1 + acc[ai][bj][m][1]; } }
    }
};
struct EpiAtomicAdd {
    float* X;
    __device__ __forceinline__ void operator()(EPI_ARGS) const {
        const int row0 = u.pm * BM + wr * 64 + fr, col0 = u.pn * BM + wc * 32 + 8 * fq;
#pragma unroll
        for (int ai = 0; ai < 2; ++ai)
#pragma unroll
            for (int m = 0; m < 4; ++m) { float* o = X + (size_t)(row0 + ai * HALF + m * 16) * DM + col0;
#pragma unroll
                for (int bj = 0; bj < 2; ++bj)
#pragma unroll
                    for (int n = 0; n < 2; ++n)
#pragma unroll
                        for (int e = 0; e < 4; ++e) (void)__hip_atomic_fetch_add(o + bj * HALF + 4 * n + e, acc[ai][bj][m][n][e], __ATOMIC_RELAXED, __HIP_MEMORY_SCOPE_AGENT); }
    }
};
struct EpiUp {
    bf16* U; int grow0; float* out;
    __device__ __forceinline__ void operator()(EPI_ARGS) const {
        const int row0 = u.pm * BM + wr * 64 + fr, col0 = u.pn * BM + wc * 32 + 8 * fq, f0 = u.pn * 128 + wc * 32 + 8 * fq;
#pragma unroll
        for (int ai = 0; ai < 2; ++ai)
#pragma unroll
            for (int m = 0; m < 4; ++m) { const int lrow = row0 + ai * HALF + m * 16, R = grow0 + lrow; bf16* rowp = U + (size_t)lrow * NUP + col0;
                float* co = nullptr;
                if (R < MP) { const int t = R & (SEQ - 1); if (t >= SEQ - 2) co = out + O_PCONV + (size_t)((R >> 14) * 2 + (t - (SEQ - 2))) * NUP + f0; }
                else { const int q = R - MP, t = q & 15; if (t >= 14) co = out + O_SCONV + (size_t)((q >> 4) * 2 + (t - 14)) * NUP + f0; }
#pragma unroll
                for (int bj = 0; bj < 2; ++bj) { const f32x4 v0 = acc[ai][bj][m][0], v1 = acc[ai][bj][m][1];
                    u32x4 w; w.x = pk2(v0[0], v0[1]); w.y = pk2(v0[2], v0[3]); w.z = pk2(v1[0], v1[1]); w.w = pk2(v1[2], v1[3]);
                    *(u32x4*)(rowp + bj * HALF) = w;
                    if (co) { *(f32x4*)(co + bj * NFF) = v0; *(f32x4*)(co + bj * NFF + 4) = v1; } } }
    }
};
__device__ __forceinline__ float dpp_prev(float cur, float prevblk, int which) {
    const int c = __float_as_int(cur), p = __float_as_int(prevblk);
    if (which == 1) { const int t = __builtin_amdgcn_mov_dpp(p, 0x121, 0xf, 0xf, true); return __int_as_float(__builtin_amdgcn_update_dpp(t, c, 0x111, 0xf, 0xf, false)); }
    const int t = __builtin_amdgcn_mov_dpp(p, 0x122, 0xf, 0xf, true); return __int_as_float(__builtin_amdgcn_update_dpp(t, c, 0x112, 0xf, 0xf, false));
}
struct EpiUpConv {
    bf16* ACT; bf16* HB; float* out; const float* cw; const float* cb; LAS unsigned char* lds;
    __device__ __forceinline__ void operator()(f32x4 (&acc)[2][2][4][2], const Unit& u, int, int, int, int) const {
        const int tid = my_tid(lds), wid = __builtin_amdgcn_readfirstlane(tid >> 6), lane = tid & 63, wr = wid >> 2, wc = wid & 3, fr = lane & 15, fq = lane >> 4;
        const int f0 = u.pn * 128 + wc * 32 + 8 * fq, rowt = u.pm * BM + wr * 64 + fr;
#pragma unroll
        for (int ai = 0; ai < 2; ++ai) { const int gidx = u.pm * 4 + ai * 2 + wr;
            if (fr < 2) { bf16* h = HB + (size_t)(gidx * 4 + fr) * NUP + f0;
#pragma unroll
                for (int bj = 0; bj < 2; ++bj) { const f32x4 v0 = acc[ai][bj][0][0], v1 = acc[ai][bj][0][1]; u32x4 w; w.x = pk2(v0[0], v0[1]); w.y = pk2(v0[2], v0[3]); w.z = pk2(v1[0], v1[1]); w.w = pk2(v1[2], v1[3]); *(u32x4*)(h + bj * NFF) = w; } }
            if (fr >= 14) { bf16* h = HB + (size_t)(gidx * 4 + 2 + (fr - 14)) * NUP + f0; const int R = rowt + ai * HALF + 48, t = R & (SEQ - 1);
                float* co = (t >= SEQ - 2) ? out + O_PCONV + (size_t)((R >> 14) * 2 + (t - (SEQ - 2))) * NUP + f0 : nullptr;
#pragma unroll
                for (int bj = 0; bj < 2; ++bj) { const f32x4 v0 = acc[ai][bj][3][0], v1 = acc[ai][bj][3][1]; u32x4 w; w.x = pk2(v0[0], v0[1]); w.y = pk2(v0[2], v0[3]); w.z = pk2(v1[0], v1[1]); w.w = pk2(v1[2], v1[3]); *(u32x4*)(h + bj * NFF) = w;
                    if (co) { *(f32x4*)(co + bj * NFF) = v0; *(f32x4*)(co + bj * NFF + 4) = v1; } } }
        }
        __builtin_amdgcn_sched_barrier(0);
        f32x4 wa0[2], wa1[2], wa2[2], ba[2], wg0[2], wg1[2], wg2[2], bg[2];
#pragma unroll
        for (int n = 0; n < 2; ++n) { const int ch = f0 + 4 * n;
            wa0[n] = *(const f32x4*)(cw + ch); wa1[n] = *(const f32x4*)(cw + NUP + ch); wa2[n] = *(const f32x4*)(cw + 2 * NUP + ch); ba[n] = *(const f32x4*)(cb + ch);
            wg0[n] = *(const f32x4*)(cw + NFF + ch); wg1[n] = *(const f32x4*)(cw + NUP + NFF + ch); wg2[n] = *(const f32x4*)(cw + 2 * NUP + NFF + ch); bg[n] = *(const f32x4*)(cb + NFF + ch); }
#pragma unroll
        for (int ai = 0; ai < 2; ++ai)
#pragma unroll
            for (int m = 0; m < 4; ++m) { float r[8];
#pragma unroll
                for (int n = 0; n < 2; ++n)
#pragma unroll
                    for (int e = 0; e < 4; ++e) { const float A = acc[ai][0][m][n][e], Gv = acc[ai][1][m][n][e];
                        const float Ap = m > 0 ? acc[ai][0][m > 0 ? m - 1 : 0][n][e] : 0.f, Gp = m > 0 ? acc[ai][1][m > 0 ? m - 1 : 0][n][e] : 0.f;
                        const float a1 = dpp_prev(A, Ap, 1), a2 = dpp_prev(A, Ap, 2), g1 = dpp_prev(Gv, Gp, 1), g2 = dpp_prev(Gv, Gp, 2);
                        const float ca = ba[n][e] + wa0[n][e] * a2 + wa1[n][e] * a1 + wa2[n][e] * A, cg = bg[n][e] + wg0[n][e] * g2 + wg1[n][e] * g1 + wg2[n][e] * Gv;
                        r[4 * n + e] = silu(ca) * cg; }
                if (!(m == 0 && fr < 2)) { u32x4 w; w.x = pk2(r[0], r[1]); w.y = pk2(r[2], r[3]); w.z = pk2(r[4], r[5]); w.w = pk2(r[6], r[7]);
                    *(u32x4*)(ACT + (size_t)(rowt + ai * HALF + m * 16) * NFF + f0) = w; }
                __builtin_amdgcn_sched_barrier(0); }
    }
};
struct EpiUpConvS {
    bf16* ACT; float* out; const float* cw; const float* cb; const float* sbuf; LAS unsigned char* lds;
    __device__ __forceinline__ void operator()(f32x4 (&acc)[2][2][4][2], const Unit& u, int, int, int, int) const {
        const int tid = my_tid(lds), wid = __builtin_amdgcn_readfirstlane(tid >> 6), lane = tid & 63, wr = wid >> 2, wc = wid & 3, fr = lane & 15, fq = lane >> 4;
        const int f0 = u.pn * 128 + wc * 32 + 8 * fq, rowt = u.pm * BM + wr * 64 + fr;
        f32x4 wa0[2], wa1[2], wa2[2], ba[2], wg0[2], wg1[2], wg2[2], bg[2];
#pragma unroll
        for (int n = 0; n < 2; ++n) { const int ch = f0 + 4 * n;
            wa0[n] = *(const f32x4*)(cw + ch); wa1[n] = *(const f32x4*)(cw + NUP + ch); wa2[n] = *(const f32x4*)(cw + 2 * NUP + ch); ba[n] = *(const f32x4*)(cb + ch);
            wg0[n] = *(const f32x4*)(cw + NFF + ch); wg1[n] = *(const f32x4*)(cw + NUP + NFF + ch); wg2[n] = *(const f32x4*)(cw + 2 * NUP + NFF + ch); bg[n] = *(const f32x4*)(cb + NFF + ch); }
#pragma unroll
        for (int ai = 0; ai < 2; ++ai)
#pragma unroll
            for (int m = 0; m < 4; ++m) { const int bseq = (u.pm * BM + ai * HALF + wr * 64 + m * 16) >> 4;
                f32x4 sa[2], sg[2];
#pragma unroll
                for (int n = 0; n < 2; ++n) { sa[n] = (f32x4){0.f, 0.f, 0.f, 0.f}; sg[n] = sa[n]; }
                if (fr >= 14) { const float* sp = sbuf + (size_t)(bseq * 2 + (fr - 14)) * NUP + f0; float* co = out + O_SCONV + (size_t)(bseq * 2 + (fr - 14)) * NUP + f0;
#pragma unroll
                    for (int n = 0; n < 2; ++n) { sa[n] = *(const f32x4*)(sp + 4 * n); sg[n] = *(const f32x4*)(sp + NFF + 4 * n); *(f32x4*)(co + 4 * n) = acc[ai][0][m][n]; *(f32x4*)(co + NFF + 4 * n) = acc[ai][1][m][n]; } }
                float r[8];
#pragma unroll
                for (int n = 0; n < 2; ++n)
#pragma unroll
                    for (int e = 0; e < 4; ++e) { const float A = acc[ai][0][m][n][e], Gv = acc[ai][1][m][n][e];
                        const float a1 = dpp_prev(A, sa[n][e], 1), a2 = dpp_prev(A, sa[n][e], 2), g1 = dpp_prev(Gv, sg[n][e], 1), g2 = dpp_prev(Gv, sg[n][e], 2);
                        const float ca = ba[n][e] + wa0[n][e] * a2 + wa1[n][e] * a1 + wa2[n][e] * A, cg = bg[n][e] + wg0[n][e] * g2 + wg1[n][e] * g1 + wg2[n][e] * Gv;
                        r[4 * n + e] = silu(ca) * cg; }
                u32x4 w; w.x = pk2(r[0], r[1]); w.y = pk2(r[2], r[3]); w.z = pk2(r[4], r[5]); w.w = pk2(r[6], r[7]);
                *(u32x4*)(ACT + (size_t)(rowt + ai * HALF + m * 16) * NFF + f0) = w;
                __builtin_amdgcn_sched_barrier(0); }
    }
};
}

__device__ __forceinline__ int wt_row(int mode, int row_off, int n) { if (mode == 1) { const int g = n >= NFF, f = g ? n - NFF : n; return 256 * (f >> 7) + 128 * g + (f & 127); } return row_off + n; }
__device__ __forceinline__ void p0_transpose_item(const float* W, int K, int N, bf16* WT, float wsc, int row_off, LAS float* scr, int item, int lane, int mode = 0) {
    const int nblk = N / 32, kb = item / nblk, nb = item % nblk, k0 = 64 * kb, n0 = 32 * nb;
#pragma unroll
    for (int i = 0; i < 8; ++i) { const int idx = lane + 64 * i, kk = idx >> 3, n4 = idx & 7; const f32x4 v = *(const f32x4*)(W + (size_t)(k0 + kk) * N + n0 + 4 * n4) * wsc;
        LAS float* d = scr + kk * 33 + 4 * n4; d[0] = v.x; d[1] = v.y; d[2] = v.z; d[3] = v.w; }
    asm volatile("s_waitcnt lgkmcnt(0)" ::: "memory");
    const int c = lane & 7;
#pragma unroll
    for (int j = 0; j < 4; ++j) { const int n = (lane >> 3) + 8 * j; const LAS float* s = scr + (8 * c) * 33 + n;
        u32x4 o; o.x = pk2(s[0 * 33], s[1 * 33]); o.y = pk2(s[2 * 33], s[3 * 33]); o.z = pk2(s[4 * 33], s[5 * 33]); o.w = pk2(s[6 * 33], s[7 * 33]);
        *(u32x4*)(WT + (size_t)wt_row(mode, row_off, n0 + n) * K + k0 + 8 * c) = o; }
    asm volatile("s_waitcnt lgkmcnt(0)" ::: "memory");
}
__device__ __forceinline__ void rms_row_to_bf16(const float* xrow, const float* g, bf16* orow, int lane) {
    const f32x4* xr = (const f32x4*)xrow + lane; f32x4 v[4]; float s = 0.f;
#pragma unroll
    for (int j = 0; j < 4; ++j) { v[j] = xr[64 * j]; s += (v[j].x * v[j].x + v[j].y * v[j].y) + (v[j].z * v[j].z + v[j].w * v[j].w); }
    const float rstd = rsqrtf(wave_sum(s) * (1.f / DM) + EPS);
    u32x2* o8 = (u32x2*)orow + lane;
#pragma unroll
    for (int j = 0; j < 4; ++j) { const f32x4 gg = ((const f32x4*)g)[lane + 64 * j]; u32x2 w; w.x = pk2(v[j].x * rstd * gg.x, v[j].y * rstd * gg.y); w.y = pk2(v[j].z * rstd * gg.z, v[j].w * rstd * gg.w); o8[64 * j] = w; }
}
__device__ __forceinline__ void rms_row2_to_bf16(const float* x0, const float* x1, const float* g, bf16* o0, bf16* o1, int lane) {
    const f32x4* xr0 = (const f32x4*)x0 + lane; const f32x4* xr1 = (const f32x4*)x1 + lane; f32x4 v[4], w[4]; float s = 0.f, t = 0.f;
#pragma unroll
    for (int j = 0; j < 4; ++j) { v[j] = xr0[64 * j]; w[j] = xr1[64 * j]; }
#pragma unroll
    for (int j = 0; j < 4; ++j) { s += (v[j].x * v[j].x + v[j].y * v[j].y) + (v[j].z * v[j].z + v[j].w * v[j].w); t += (w[j].x * w[j].x + w[j].y * w[j].y) + (w[j].z * w[j].z + w[j].w * w[j].w); }
    const float r0 = rsqrtf(wave_sum(s) * (1.f / DM) + EPS), r1 = rsqrtf(wave_sum(t) * (1.f / DM) + EPS);
    u32x2* p0 = (u32x2*)o0 + lane; u32x2* p1 = (u32x2*)o1 + lane;
#pragma unroll
    for (int j = 0; j < 4; ++j) { const f32x4 gg = ((const f32x4*)g)[lane + 64 * j]; u32x2 a, b;
        a.x = pk2(v[j].x * r0 * gg.x, v[j].y * r0 * gg.y); a.y = pk2(v[j].z * r0 * gg.z, v[j].w * r0 * gg.w); b.x = pk2(w[j].x * r1 * gg.x, w[j].y * r1 * gg.y); b.y = pk2(w[j].z * r1 * gg.z, w[j].w * r1 * gg.w);
        p0[64 * j] = a; p1[64 * j] = b; }
}
__device__ __forceinline__ void rms_row_f32_inplace(float* xrow, const float* g, int lane) {
    f32x4* xr = (f32x4*)xrow + lane; f32x4 v[4]; float s = 0.f;
#pragma unroll
    for (int j = 0; j < 4; ++j) { v[j] = xr[64 * j]; s += (v[j].x * v[j].x + v[j].y * v[j].y) + (v[j].z * v[j].z + v[j].w * v[j].w); }
    const float rstd = rsqrtf(wave_sum(s) * (1.f / DM) + EPS);
#pragma unroll
    for (int j = 0; j < 4; ++j) { const f32x4 gg = ((const f32x4*)g)[lane + 64 * j]; xr[64 * j] = v[j] * rstd * gg; }
}

__device__ __forceinline__ void row_post(bf16* Z, bf16* CQN, bf16* CKV, bf16* KR, float* out, const float* qg, const float* kvg, int r, int lane) {
    bf16* z = Z + (size_t)r * NZ; const float pos = (float)row_pos(r);
    { const u32x2 raw = *(const u32x2*)(z + 4 * lane); const float v0 = bflo(raw.x), v1 = bfhi(raw.x), v2 = bflo(raw.y), v3 = bfhi(raw.y);
      const float rstd = rsqrtf(wave_sum((v0 * v0 + v1 * v1) + (v2 * v2 + v3 * v3)) * (1.f / 256.f) + EPS); const f32x4 g = *(const f32x4*)(qg + 4 * lane);
      u32x2 w; w.x = pk2(v0 * rstd * g.x, v1 * rstd * g.y); w.y = pk2(v2 * rstd * g.z, v3 * rstd * g.w); *(u32x2*)(CQN + (size_t)r * 256 + 4 * lane) = w; }
    { const unsigned raw = *(const unsigned*)(z + ZC_CKV + 2 * lane); const float v0 = bflo(raw), v1 = bfhi(raw);
      const float rstd = rsqrtf(wave_sum(v0 * v0 + v1 * v1) * (1.f / 128.f) + EPS); const f32x2 g = *(const f32x2*)(kvg + 2 * lane);
      const float y0 = v0 * rstd * g.x, y1 = v1 * rstd * g.y;
      float* o = (r < MP ? out + O_PCKV + (size_t)r * 128 : out + O_SCKV + (size_t)(r - MP) * 128) + 2 * lane; *(f32x2*)o = (f32x2){y0, y1};
      if (r < MP) *(unsigned*)(CKV + (size_t)r * 128 + 2 * lane) = pk2(y0, y1); }
    if (lane < 16) { const float x1 = bf2f(z[ZC_KR + lane]), x2 = bf2f(z[ZC_KR + 16 + lane]); const float inv = ex2f(-(float)lane * (2.0f / 32.0f) * LG2_10000);
      float s, c; sincos_rev(pos * inv, s, c); const float o1 = x1 * c - x2 * s, o2 = x2 * c + x1 * s;
      float* o = (r < MP ? out + O_PKR + (size_t)r * 32 : out + O_SKR + (size_t)(r - MP) * 32); o[lane] = o1; o[16 + lane] = o2;
      if (r < MP) { KR[(size_t)r * 32 + lane] = f2bf(o1); KR[(size_t)r * 32 + 16 + lane] = f2bf(o2); } }
    { const float inv = ex2f(-(float)lane * (1.0f / 63.0f) * LG2_10000); float s, c; sincos_rev(pos * inv, s, c);
#pragma unroll
      for (int hh = 0; hh < 4; ++hh) {
          bf16* q = z + ZC_RQ + hh * 128; const float a1 = bf2f(q[lane]), a2 = bf2f(q[64 + lane]); q[lane] = f2bf(a1 * c - a2 * s); q[64 + lane] = f2bf(a2 * c + a1 * s);
          bf16* k = z + ZC_RK + hh * 128; const float b1 = bf2f(k[lane]), b2 = bf2f(k[64 + lane]); const float ks = 0.08838834764831845f;
          k[lane] = f2bf((b1 * c - b2 * s) * ks); k[64 + lane] = f2bf((b2 * c + b1 * s) * ks); } }
}
__device__ __forceinline__ bf16x8 pack8(const f32x16& p, int b) {
    u32x4 w; w.x = pk2(p[b + 0], p[b + 1]); w.y = pk2(p[b + 2], p[b + 3]); w.z = pk2(p[b + 4], p[b + 5]); w.w = pk2(p[b + 6], p[b + 7]); return __builtin_bit_cast(bf16x8, w);
}
template <int DQK, int DV, int MODE>
__device__ __forceinline__ void flash_unit(LAS unsigned char* lds, const bf16* Qp, int qpitch, const bf16* K0, int kpitch, const bf16* K1, const bf16* VT, int vpitch,
                                           bf16* Op, int opitch, int NT, int jbase, int qpos0) {
    constexpr int KP = DQK + 8, VP = 68, KB = 64 * KP * 2, VB = DV * VP * 2, KCH = DQK / 8, NKC = 64 * KCH, KPT = (NKC + 511) / 512, NVC = DV * 8, VPT = NVC / 512, ND0 = DQK / 16, NDB = DV / 32;
    constexpr bool QREG = (MODE == 0);
    const int tid_ = my_tid(lds); const int tid = tid_, lane = tid & 63, r32 = lane & 31, hi = lane >> 5; const int wid = __builtin_amdgcn_readfirstlane(tid >> 6);
    const bf16* Qrow = Qp + (size_t)(wid * 32 + r32) * qpitch + 8 * hi;
    bf16x8 qf[QREG ? ND0 : 1];
    if constexpr (QREG) {
#pragma unroll
        for (int d0 = 0; d0 < ND0; ++d0) qf[d0] = *(const bf16x8*)(Qrow + 16 * d0);
        const float pos = (float)(qpos0 + wid * 32 + r32);
        const u32x4 xa = __builtin_bit_cast(u32x4, qf[ND0 - 2]), xb = __builtin_bit_cast(u32x4, qf[ND0 - 1]); u32x4 ra, rb;
#pragma unroll
        for (int e = 0; e < 4; ++e) { const float a0 = bflo(xa[e]), a1 = bfhi(xa[e]), b0 = bflo(xb[e]), b1 = bfhi(xb[e]);
            float s0_, c0_, s1_, c1_; sincos_rev(pos * ex2f(-(float)(8 * hi + 2 * e) * (2.0f / 32.0f) * LG2_10000), s0_, c0_); sincos_rev(pos * ex2f(-(float)(8 * hi + 2 * e + 1) * (2.0f / 32.0f) * LG2_10000), s1_, c1_);
            ra[e] = pk2(a0 * c0_ - b0 * s0_, a1 * c1_ - b1 * s1_); rb[e] = pk2(b0 * c0_ + a0 * s0_, b1 * c1_ + a1 * s1_); }
        qf[ND0 - 2] = __builtin_bit_cast(bf16x8, ra); qf[ND0 - 1] = __builtin_bit_cast(bf16x8, rb);
    }
    u32x4 kreg[KPT], vreg[VPT];
#define FL_GLOAD(j) do { \
    _Pragma("unroll") for (int i_ = 0; i_ < KPT; ++i_) { const int ci = tid + 512 * i_; if (ci < NKC) { const int key = ci / KCH, ch = ci - key * KCH; \
        const bf16* src; if (MODE == 0 && ch >= 8) src = K1 + (size_t)(64 * (j) + key) * 32 + (ch - 8) * 8; else src = K0 + (size_t)(64 * (j) + key) * kpitch + ch * 8; \
        kreg[i_] = *(const u32x4*)src; } } \
    _Pragma("unroll") for (int i_ = 0; i_ < VPT; ++i_) { const int ci = tid + 512 * i_; const int d = ci >> 3, ch = ci & 7; vreg[i_] = *(const u32x4*)(VT + (size_t)d * vpitch + 64 * (j) + ch * 8); } } while (0)
#define FL_LSTORE(buf) do { \
    _Pragma("unroll") for (int i_ = 0; i_ < KPT; ++i_) { const int ci = tid + 512 * i_; if (ci < NKC) { const int key = ci / KCH, ch = ci - key * KCH; \
        *(LAS u32x4*)(lds + (buf) * KB + (key * KP + ch * 8) * 2) = kreg[i_]; } } \
    _Pragma("unroll") for (int i_ = 0; i_ < VPT; ++i_) { const int ci = tid + 512 * i_; const int d = ci >> 3, ch = ci & 7; LAS u32x2* p_ = (LAS u32x2*)(lds + 2 * KB + (buf) * VB + (d * VP + ch * 8) * 2); \
        p_[0] = (u32x2){vreg[i_].x, vreg[i_].y}; p_[1] = (u32x2){vreg[i_].z, vreg[i_].w}; } } while (0)
#define FL_GLOADK(j) do { \
    _Pragma("unroll") for (int i_ = 0; i_ < KPT; ++i_) { const int ci = tid + 512 * i_; if (ci < NKC) { const int key = ci / KCH, ch = ci - key * KCH; \
        kreg[i_] = *(const u32x4*)(K0 + (size_t)(64 * (j) + key) * kpitch + ch * 8); } } } while (0)
#define FL_LSTOREK(buf) do { \
    _Pragma("unroll") for (int i_ = 0; i_ < KPT; ++i_) { const int ci = tid + 512 * i_; if (ci < NKC) { const int key = ci / KCH, ch = ci - key * KCH; \
        *(LAS u32x4*)(lds + (buf) * KB + (key * KP + ch * 8) * 2) = kreg[i_]; } } } while (0)
#define FL_GLOADV(j) do { \
    _Pragma("unroll") for (int i_ = 0; i_ < VPT; ++i_) { const int ci = tid + 512 * i_; const int d = ci >> 3, ch = ci & 7; kreg[i_] = *(const u32x4*)(VT + (size_t)d * vpitch + 64 * (j) + ch * 8); } } while (0)
#define FL_LSTOREV(buf) do { \
    _Pragma("unroll") for (int i_ = 0; i_ < VPT; ++i_) { const int ci = tid + 512 * i_; const int d = ci >> 3, ch = ci & 7; LAS u32x2* p_ = (LAS u32x2*)(lds + 2 * KB + (buf) * VB + (d * VP + ch * 8) * 2); \
        p_[0] = (u32x2){kreg[i_].x, kreg[i_].y}; p_[1] = (u32x2){kreg[i_].z, kreg[i_].w}; } } while (0)
    static_assert(MODE == 0 || VPT <= KPT, "MODE 1 stages V through the K registers");
    f32x16 o[NDB];
#pragma unroll
    for (int i = 0; i < NDB; ++i)
#pragma unroll
        for (int r = 0; r < 16; ++r) o[i][r] = 0.f;
    float mref = 0.f, lrun = 0.f;
    const int jmax = jbase + (wid >> 1);
    FL_GLOAD(0); FL_LSTORE(0); __syncthreads();
    f32x16 s0, s1, negt;
#pragma unroll
    for (int r = 0; r < 16; ++r) negt[r] = 0.f;
#define FL_X(tj) do { \
        if constexpr (MODE != 0) { const float negm = -mref; _Pragma("unroll") for (int r = 0; r < 16; ++r) { s0[r] = negm; s1[r] = negm; } } \
        const LAS unsigned char* kb = lds + ((tj) & 1) * KB + (r32 * KP + 8 * hi) * 2; \
        constexpr int GD = (ND0 <= 6) ? ND0 : 2; \
        _Pragma("unroll") for (int g0 = 0; g0 < ND0; g0 += GD) { \
            bf16x8 ka[GD], kc[GD], qq[GD]; \
            _Pragma("unroll") for (int i = 0; i < GD; ++i) { ka[i] = *(const LAS bf16x8*)(kb + (g0 + i) * 32); kc[i] = *(const LAS bf16x8*)(kb + 32 * KP * 2 + (g0 + i) * 32); \
                if constexpr (QREG) qq[i] = qf[g0 + i]; else qq[i] = *(const bf16x8*)(Qrow + 16 * (g0 + i)); } \
            __builtin_amdgcn_sched_barrier(0); \
            _Pragma("unroll") for (int i = 0; i < GD; ++i) { if (MODE == 0 && g0 == 0 && i == 0) { s0 = MFMA32(ka[i], qq[i], negt); s1 = MFMA32(kc[i], qq[i], negt); } else { s0 = MFMA32(ka[i], qq[i], s0); s1 = MFMA32(kc[i], qq[i], s1); } } \
            __builtin_amdgcn_sched_barrier(0); \
        } } while (0)
#define FL_Y(tj) do { \
        const LAS unsigned char* vb = lds + 2 * KB + ((tj) & 1) * VB + (r32 * VP + 4 * hi) * 2; \
        constexpr int VPRE = NDB <= 4 ? NDB : 1;     \
        u32x2 vl[VPRE * 4], vh[VPRE * 4]; \
        _Pragma("unroll") for (int db = 0; db < VPRE; ++db) _Pragma("unroll") for (int ks = 0; ks < 4; ++ks) { const LAS unsigned char* vp = vb + (db * 32 * VP + 16 * ks) * 2; vl[db * 4 + ks] = *(const LAS u32x2*)vp; vh[db * 4 + ks] = *(const LAS u32x2*)(vp + 16); } \
        __builtin_amdgcn_sched_barrier(0); \
        float mxa = fmaxf(fmaxf(s0[0], s0[1]), s0[2]), mxb = fmaxf(fmaxf(s1[0], s1[1]), s1[2]); \
        _Pragma("unroll") for (int r = 3; r < 15; r += 2) { mxa = fmaxf(fmaxf(mxa, s0[r]), s0[r + 1]); mxb = fmaxf(fmaxf(mxb, s1[r]), s1[r + 1]); } \
        float mx = fmaxf(fmaxf(mxa, s0[15]), fmaxf(mxb, s1[15])); \
        mx = half_max(mx); \
        if ((tj) == 0 || __any(mx > 8.0f)) { \
            const float dl = ((tj) == 0 || mx > 8.0f) ? mx : 0.f; mref += dl; \
            const float al = __builtin_amdgcn_exp2f(-dl); lrun *= al; \
            if constexpr (MODE == 0) { const float nm_ = -mref; _Pragma("unroll") for (int r = 0; r < 16; ++r) negt[r] = nm_; } \
            _Pragma("unroll") for (int r = 0; r < 16; ++r) { s0[r] -= dl; s1[r] -= dl; } \
            _Pragma("unroll") for (int i = 0; i < NDB; ++i) _Pragma("unroll") for (int r = 0; r < 16; ++r) o[i][r] *= al; \
        } \
        float ls = 0.f; \
        _Pragma("unroll") for (int r = 0; r < 16; ++r) { s0[r] = __builtin_amdgcn_exp2f(s0[r]); s1[r] = __builtin_amdgcn_exp2f(s1[r]); ls += s0[r] + s1[r]; } \
        lrun += ls; \
        bf16x8 pf[4]; pf[0] = pack8(s0, 0); pf[1] = pack8(s0, 8); pf[2] = pack8(s1, 0); pf[3] = pack8(s1, 8); \
        __builtin_amdgcn_sched_barrier(0); \
        _Pragma("unroll") for (int db = 0; db < VPRE; ++db) _Pragma("unroll") for (int ks = 0; ks < 4; ++ks) { \
            const u32x4 v4 = (u32x4){vl[db * 4 + ks].x, vl[db * 4 + ks].y, vh[db * 4 + ks].x, vh[db * 4 + ks].y}; \
            o[db] = MFMA32(__builtin_bit_cast(bf16x8, v4), pf[ks], o[db]); } \
        _Pragma("unroll") for (int d2 = VPRE; d2 < NDB; ++d2) { u32x2 wl[4], wh[4]; \
            _Pragma("unroll") for (int q = 0; q < 4; ++q) { const LAS unsigned char* vp = vb + (d2 * 32 * VP + 16 * q) * 2; wl[q] = *(const LAS u32x2*)vp; wh[q] = *(const LAS u32x2*)(vp + 16); } \
            __builtin_amdgcn_sched_barrier(0); \
            _Pragma("unroll") for (int q = 0; q < 4; ++q) { const u32x4 v4 = (u32x4){wl[q].x, wl[q].y, wh[q].x, wh[q].y}; o[d2] = MFMA32(__builtin_bit_cast(bf16x8, v4), pf[q], o[d2]); } \
            __builtin_amdgcn_sched_barrier(0); } } while (0)
    for (int j = 0; j < NT; ++j) {
        const int buf = j & 1;
        if (j + 1 < NT) { if constexpr (MODE == 1) { FL_GLOADK(j + 1); FL_LSTOREK(buf ^ 1); FL_GLOADV(j + 1); FL_LSTOREV(buf ^ 1); } else { FL_GLOAD(j + 1); } }
        if (MODE == 1 || j <= jmax) { FL_X(j); FL_Y(j); }
        if constexpr (MODE == 0) { if (j + 1 < NT) { FL_LSTORE(buf ^ 1); } }
        __syncthreads();
    }
#undef FL_X
#undef FL_Y
    { const float lt = half_sum(lrun), inv = 1.f / lt;
      bf16* orow = Op + (size_t)(wid * 32 + r32) * opitch + 4 * hi;
#pragma unroll
      for (int db = 0; db < NDB; ++db)
#pragma unroll
          for (int rg = 0; rg < 4; ++rg) { u32x2 w; w.x = pk2(o[db][4 * rg] * inv, o[db][4 * rg + 1] * inv); w.y = pk2(o[db][4 * rg + 2] * inv, o[db][4 * rg + 3] * inv);
              *(u32x2*)(orow + 32 * db + 8 * rg) = w; } }
#undef FL_GLOAD
#undef FL_LSTORE
#undef FL_GLOADK
#undef FL_LSTOREK
#undef FL_GLOADV
#undef FL_LSTOREV
}

__device__ __forceinline__ void ret_kv_item(LAS unsigned char* lds, const bf16* Z, bf16* AT, int b, int c, int hh, float lg) {
    LAS bf16* KT = (LAS bf16*)lds; LAS bf16* VTt = KT + 128 * 72;
    const int tid_ = my_tid(lds); const int tid = tid_, lane = tid & 63, r32 = lane & 31, hi = lane >> 5; const int wid = __builtin_amdgcn_readfirstlane(tid >> 6);
    const int rowbase = b * SEQ + 64 * c;
#pragma unroll
    for (int i = 0; i < 2; ++i) { const int ci = tid + 512 * i, l = ci & 63, dc = ci >> 6; const bf16* zr = Z + (size_t)(rowbase + l) * NZ + hh * 128 + dc * 8;
        const u32x4 kr = *(const u32x4*)(zr + ZC_RK), vr = *(const u32x4*)(zr + ZC_RV); const float dec = ex2f((float)(63 - l) * lg);
#pragma unroll
        for (int e = 0; e < 4; ++e) { const unsigned kw = kr[e], vw = vr[e]; const int d = 8 * dc + 2 * e;
            KT[d * 72 + l] = f2bf(bflo(kw) * dec); KT[(d + 1) * 72 + l] = f2bf(bfhi(kw) * dec);
            VTt[d * 72 + l] = (bf16)(vw & 0xffffu); VTt[(d + 1) * 72 + l] = (bf16)(vw >> 16); } }
    __syncthreads();
    const int eb = wid >> 1, db0 = 2 * (wid & 1);
    f32x16 a0, a1;
#pragma unroll
    for (int r = 0; r < 16; ++r) { a0[r] = 0.f; a1[r] = 0.f; }
#pragma unroll
    for (int ks = 0; ks < 4; ++ks) {
        const bf16x8 af = *(const LAS bf16x8*)(VTt + (32 * eb + r32) * 72 + 16 * ks + 8 * hi);
        const bf16x8 b0 = *(const LAS bf16x8*)(KT + (32 * db0 + r32) * 72 + 16 * ks + 8 * hi), b1 = *(const LAS bf16x8*)(KT + (32 * db0 + 32 + r32) * 72 + 16 * ks + 8 * hi);
        a0 = MFMA32(af, b0, a0); a1 = MFMA32(af, b1, a1);
    }
    bf16* o = AT + (size_t)((b * 256 + c) * 4 + hh) * 16384;
#pragma unroll
    for (int r = 0; r < 16; ++r) { const int e = 32 * eb + crow(r, hi); o[e * 128 + 32 * db0 + r32] = f2bf(a0[r]); o[e * 128 + 32 * db0 + 32 + r32] = f2bf(a1[r]); }
    __syncthreads();
}
__device__ __forceinline__ void ret_scan(LAS unsigned char* lds, bf16* AT, float* out, int G, const float* lgs) {
    const int t_ = my_tid(lds);
    for (int idx = blockIdx.x * 256 + t_; t_ < 256 && idx < 2 * 4 * 128 * 64; idx += G * 256) {
        const int d = (idx & 63) * 2, e = (idx >> 6) & 127, hh = (idx >> 13) & 3, b = idx >> 15;
        const float g64 = ex2f(64.f * lgs[hh]);
        unsigned* p = (unsigned*)(AT + (size_t)(b * 256 * 4 + hh) * 16384 + e * 128 + d); float S0 = 0.f, S1 = 0.f;
        for (int c = 0; c < 256; c += 8) { unsigned a[8];
#pragma unroll
            for (int i = 0; i < 8; ++i) a[i] = p[(size_t)(c + i) * 32768];
#pragma unroll
            for (int i = 0; i < 8; ++i) { p[(size_t)(c + i) * 32768] = pk2(S0, S1); S0 = g64 * S0 + bflo(a[i]); S1 = g64 * S1 + bfhi(a[i]); } }
        float* o = out + O_PRET + (size_t)((b * 4 + hh) * 128 + d) * 128 + e; o[0] = S0; o[128] = S1;
    }
}
__device__ __forceinline__ void ret_out_item(LAS unsigned char* lds, const bf16* Z, const bf16* AT, const float* gn, bf16* MIXED, int b, int c, const float* lgs) {
    LAS bf16* VT4 = (LAS bf16*)lds;
    const int tid_ = my_tid(lds); const int tid = tid_, lane = tid & 63, r32 = lane & 31, hi = lane >> 5; const int wid = __builtin_amdgcn_readfirstlane(tid >> 6);
    const int rowbase = b * SEQ + 64 * c;
#pragma unroll
    for (int i = 0; i < 8; ++i) { const int ci = tid + 512 * i, l = ci & 63, ec = ci >> 6; const u32x4 vr = *(const u32x4*)(Z + (size_t)(rowbase + l) * NZ + ZC_RV + ec * 8);
#pragma unroll
        for (int e = 0; e < 4; ++e) { const unsigned vw = vr[e]; VT4[(8 * ec + 2 * e) * 72 + l] = (bf16)(vw & 0xffffu); VT4[(8 * ec + 2 * e + 1) * 72 + l] = (bf16)(vw >> 16); } }
    __syncthreads();
    const int hh = wid >> 1, lb = wid & 1, l = 32 * lb + r32, row = rowbase + l; const float lg = lgs[hh];
    bf16x8 qf[8];
#pragma unroll
    for (int ds = 0; ds < 8; ++ds) qf[ds] = *(const bf16x8*)(Z + (size_t)row * NZ + ZC_RQ + hh * 128 + 16 * ds + 8 * hi);
    f32x16 acc[4];
#pragma unroll
    for (int i = 0; i < 4; ++i)
#pragma unroll
        for (int r = 0; r < 16; ++r) acc[i][r] = 0.f;
    const bf16* Sp = AT + (size_t)((b * 256 + c) * 4 + hh) * 16384;
#pragma unroll
    for (int eb = 0; eb < 4; ++eb)
#pragma unroll
        for (int ds = 0; ds < 8; ++ds) { const bf16x8 w = *(const bf16x8*)(Sp + (32 * eb + r32) * 128 + 16 * ds + 8 * hi);
            acc[eb] = MFMA32(w, qf[ds], acc[eb]); if (ds == 3 || ds == 7) __builtin_amdgcn_sched_barrier(0); }
    { const float qd = ex2f((float)(l + 1) * lg);
#pragma unroll
      for (int i = 0; i < 4; ++i)
#pragma unroll
          for (int r = 0; r < 16; ++r) acc[i][r] *= qd; }
#pragma unroll
    for (int mb = 0; mb < 2; ++mb) {
        if (mb <= lb) {
            f32x16 st;
#pragma unroll
            for (int r = 0; r < 16; ++r) st[r] = 0.f;
#pragma unroll
            for (int ds = 0; ds < 8; ++ds) { const bf16x8 kf = *(const bf16x8*)(Z + (size_t)(rowbase + 32 * mb + r32) * NZ + ZC_RK + hh * 128 + 16 * ds + 8 * hi); st = MFMA32(kf, qf[ds], st); }
#pragma unroll
            for (int r = 0; r < 16; ++r) { const int m = 32 * mb + crow(r, hi), diff = l - m; st[r] = diff >= 0 ? st[r] * ex2f((float)diff * lg) : 0.f; }
            const bf16x8 pf0 = pack8(st, 0), pf1 = pack8(st, 8);
#pragma unroll
            for (int eb = 0; eb < 4; ++eb)
#pragma unroll
                for (int kk = 0; kk < 2; ++kk) { const LAS bf16* vp = VT4 + (hh * 128 + 32 * eb + r32) * 72 + 16 * (2 * mb + kk) + 4 * hi;
                    const u32x2 lo = *(const LAS u32x2*)vp, h2 = *(const LAS u32x2*)(vp + 8); const u32x4 v4 = (u32x4){lo.x, lo.y, h2.x, h2.y};
                    acc[eb] = MFMA32(__builtin_bit_cast(bf16x8, v4), kk ? pf1 : pf0, acc[eb]); }
        }
    }
    float s = 0.f;
#pragma unroll
    for (int i = 0; i < 4; ++i)
#pragma unroll
        for (int r = 0; r < 16; ++r) s += acc[i][r];
    s = half_sum(s); const float mean = s * (1.f / 128.f); float v = 0.f;
#pragma unroll
    for (int i = 0; i < 4; ++i)
#pragma unroll
        for (int r = 0; r < 16; ++r) { const float dd = acc[i][r] - mean; v += dd * dd; }
    v = half_sum(v); const float rstd = rsqrtf(v * (1.f / 128.f) + EPS);
#pragma unroll
    for (int eb = 0; eb < 4; ++eb)
#pragma unroll
        for (int rg = 0; rg < 4; ++rg) { const int e0 = 32 * eb + 8 * rg + 4 * hi;
            const u32x2 gt = *(const u32x2*)(Z + (size_t)row * NZ + ZC_RG + hh * 128 + e0); const f32x4 gg = *(const f32x4*)(gn + hh * 128 + e0);
            const float y0 = (acc[eb][4 * rg] - mean) * rstd * gg.x * silu(bflo(gt.x)), y1 = (acc[eb][4 * rg + 1] - mean) * rstd * gg.y * silu(bfhi(gt.x));
            const float y2 = (acc[eb][4 * rg + 2] - mean) * rstd * gg.z * silu(bflo(gt.y)), y3 = (acc[eb][4 * rg + 3] - mean) * rstd * gg.w * silu(bfhi(gt.y));
            u32x2 w; w.x = pk2(y0, y1); w.y = pk2(y2, y3); *(u32x2*)(MIXED + (size_t)row * 1024 + 512 + hh * 128 + e0) = w; }
    __syncthreads();
}
__device__ __forceinline__ void ret_sample_item(LAS unsigned char* lds, const bf16* Z, const float* S0, const float* gn, float* out, bf16* MIXED, int b, int hh, float lg) {
    LAS float* qT = (LAS float*)lds;
    LAS float* kT = qT + 2048;
    LAS float* vS = kT + 2048;
    LAS float* inn = vS + 2048;
    LAS float* QSp = inn + 256;
    LAS float* oS = QSp + 8192;
    const int tid_ = my_tid(lds); const int tid = tid_, lane = tid & 63; const int wid = __builtin_amdgcn_readfirstlane(tid >> 6);
    const int rowbase = MP + b * 16;
#pragma unroll
    for (int i = 0; i < 4; ++i) { const int idx = tid + 512 * i, l = idx >> 7, d = idx & 127; const bf16* zr = Z + (size_t)(rowbase + l) * NZ + hh * 128 + d;
        qT[d * 16 + l] = bf2f(zr[ZC_RQ]); kT[d * 16 + l] = bf2f(zr[ZC_RK]); vS[l * 128 + d] = bf2f(zr[ZC_RV]); }
    __syncthreads();
    if (tid < 256) { const int l = tid >> 4, m = tid & 15; float s = 0.f;
        if (m <= l) { for (int d = 0; d < 128; ++d) s += qT[d * 16 + l] * kT[d * 16 + m]; s *= ex2f((float)(l - m) * lg); }
        inn[l * 16 + m] = s; }
    { const int e = tid & 127, dg = tid >> 7; float vr[16], qs[16], gk[16];
#pragma unroll
      for (int l = 0; l < 16; ++l) { vr[l] = vS[l * 128 + e]; qs[l] = 0.f; gk[l] = ex2f((float)(15 - l) * lg); }
      const float g16 = ex2f(16.f * lg); const size_t sb = (size_t)((b * 4 + hh) * 128) * 128;
      for (int dd = 0; dd < 32; ++dd) { const int d = dg * 32 + dd; const float s0 = S0[sb + (size_t)d * 128 + e]; float kv = 0.f;
#pragma unroll
          for (int l4 = 0; l4 < 4; ++l4) { const f32x4 k4 = *(const LAS f32x4*)(kT + d * 16 + 4 * l4), q4 = *(const LAS f32x4*)(qT + d * 16 + 4 * l4);
#pragma unroll
              for (int j = 0; j < 4; ++j) { kv += k4[j] * gk[4 * l4 + j] * vr[4 * l4 + j]; qs[4 * l4 + j] += q4[j] * s0; } }
          out[O_SRET + sb + (size_t)d * 128 + e] = g16 * s0 + kv; }
#pragma unroll
      for (int l = 0; l < 16; ++l) QSp[(dg * 16 + l) * 128 + e] = qs[l]; }
    __syncthreads();
    { const int e = tid & 127, lgp = tid >> 7;
#pragma unroll
      for (int li = 0; li < 4; ++li) { const int l = 4 * lgp + li; float a = (QSp[(0 * 16 + l) * 128 + e] + QSp[(1 * 16 + l) * 128 + e]) + (QSp[(2 * 16 + l) * 128 + e] + QSp[(3 * 16 + l) * 128 + e]);
          a *= ex2f((float)(l + 1) * lg);
          for (int m = 0; m <= l; ++m) a += inn[l * 16 + m] * vS[m * 128 + e];
          oS[l * 128 + e] = a; } }
    __syncthreads();
#pragma unroll
    for (int li = 0; li < 2; ++li) { const int l = 2 * wid + li, row = rowbase + l; const float x0 = oS[l * 128 + lane], x1 = oS[l * 128 + 64 + lane];
        const float mean = wave_sum(x0 + x1) * (1.f / 128.f); const float d0 = x0 - mean, d1 = x1 - mean; const float rstd = rsqrtf(wave_sum(d0 * d0 + d1 * d1) * (1.f / 128.f) + EPS);
        const bf16* zg = Z + (size_t)row * NZ + ZC_RG + hh * 128; bf16* mo = MIXED + (size_t)row * 1024 + 512 + hh * 128;
        mo[lane] = f2bf(d0 * rstd * gn[hh * 128 + lane] * silu(bf2f(zg[lane]))); mo[64 + lane] = f2bf(d1 * rstd * gn[hh * 128 + 64 + lane] * silu(bf2f(zg[64 + lane]))); }
    __syncthreads();
}
constexpr int AS_NK = PAST + 16, AS_NT = (AS_NK + 63) / 64;
__device__ __forceinline__ void mla_sample_unit(LAS unsigned char* lds, size_t ws_q, size_t ws_olat, size_t ws_mixed, int b) {
    constexpr int DQK = 160, DV = 128, KP = DQK + 8, VP = 68, KB = 64 * KP * 2, VB = DV * VP * 2, ND0 = DQK / 16, NDB = DV / 32, QA_BYTES = 128 * KP * 2, KV0 = QA_BYTES, QS_OFF = QA_BYTES;
    const int tid_ = my_tid(lds); const int tid = tid_, lane = tid & 63, r32 = lane & 31, hi = lane >> 5; const int wid = __builtin_amdgcn_readfirstlane(tid >> 6);
    LAS float* QS = (LAS float*)(lds + QS_OFF);
    const int rowbase = MP + b * 16;
    { const bf16* Q = WSB(ws_q); const float* w_uk = INP(14); LAS bf16* QA = (LAS bf16*)lds;
#pragma unroll
    for (int i = 0; i < 24; ++i) { const int idx = tid + 512 * i, t = idx / 768, c = idx - t * 768; QS[idx] = bf2f(Q[(size_t)(rowbase + t) * 768 + c]); }
    __syncthreads();
    { const int r = tid & 127, hg = tid >> 7;
#pragma unroll 1
      for (int h2 = 0; h2 < 2; ++h2) { const int h = 2 * hg + h2; const float* wr = w_uk + (size_t)(r * 8 + h) * 64; float a[16];
#pragma unroll
          for (int t = 0; t < 16; ++t) a[t] = 0.f;
#pragma unroll 4
          for (int d4 = 0; d4 < 16; ++d4) { const f32x4 w = *(const f32x4*)(wr + 4 * d4);
#pragma unroll
              for (int t = 0; t < 16; ++t) { const f32x4 q = *(const LAS f32x4*)(QS + t * 768 + h * 96 + 4 * d4); a[t] += (w.x * q.x + w.y * q.y) + (w.z * q.z + w.w * q.w); } }
#pragma unroll
          for (int t = 0; t < 16; ++t) QA[(h * 16 + t) * KP + r] = f2bf(a[t]); }
#pragma unroll
      for (int i = 0; i < 8; ++i) { const int idx = tid + 512 * i, row = idx >> 5, i32 = idx & 31, ii = i32 & 15, h = row >> 4, t = row & 15;
          const float x1 = QS[t * 768 + h * 96 + 64 + ii], x2 = QS[t * 768 + h * 96 + 80 + ii]; float sn, cs; sincos_rev((float)(PAST + t) * ex2f(-(float)ii * (2.0f / 32.0f) * LG2_10000), sn, cs);
          QA[row * KP + 128 + i32] = f2bf(i32 < 16 ? x1 * cs - x2 * sn : x2 * cs + x1 * sn); } }
    }
    __syncthreads();
    const float *c_ckv = INP(2), *c_kr = INP(3); const float* n_ckv = OUTP() + O_SCKV; const float* n_kr = OUTP() + O_SKR;
    const LAS unsigned char* qb_ = lds + (((wid & 3) * 32 + r32) * KP + 8 * hi) * 2;
    f32x4 pre[10];
#define AS_GLOAD(pi) do { _Pragma("unroll") for (int i_ = 0; i_ < 10; ++i_) { const int cj = tl + 512 * i_, sl = cj >= 2560, ci = cj - 2560 * sl, key = (ci & 15) + 16 * ((ci >> 6) & 3), ch = ((ci >> 4) & 3) + 4 * (ci >> 8), kg = 64 * (2 * (pi) + sl) + key; \
        const float* src = kg < PAST ? (ch < 32 ? c_ckv + ((size_t)(b * PAST + kg) * 128 + 4 * ch) : c_kr + ((size_t)(b * PAST + kg) * 32 + 4 * (ch - 32))) \
                                     : (ch < 32 ? n_ckv + ((size_t)(b * 16 + (kg - PAST)) * 128 + 4 * ch) : n_kr + ((size_t)(b * 16 + (kg - PAST)) * 32 + 4 * (ch - 32))); \
        pre[i_] = kg < AS_NK ? *(const f32x4*)src : (f32x4){0.f, 0.f, 0.f, 0.f}; } } while (0)
#define AS_LSTORE() do { _Pragma("unroll") for (int i_ = 0; i_ < 10; ++i_) { const int cj = tl + 512 * i_, sl = cj >= 2560, ci = cj - 2560 * sl, key = (ci & 15) + 16 * ((ci >> 6) & 3), ch = ((ci >> 4) & 3) + 4 * (ci >> 8); \
        const unsigned w0_ = pk2(pre[i_].x, pre[i_].y), w1_ = pk2(pre[i_].z, pre[i_].w); \
        *(LAS u32x2*)(lds + KV0 + sl * KB + (key * KP + 4 * ch) * 2) = (u32x2){w0_, w1_}; \
        if (ch < 32) { LAS bf16* vt_ = (LAS bf16*)(lds + KV0 + 2 * KB + sl * VB) + (4 * ch) * VP + key; \
            vt_[0] = (bf16)(w0_ & 0xffffu); vt_[VP] = (bf16)(w0_ >> 16); vt_[2 * VP] = (bf16)(w1_ & 0xffffu); vt_[3 * VP] = (bf16)(w1_ >> 16); } } } while (0)
    f32x16 o[NDB];
#pragma unroll
    for (int i = 0; i < NDB; ++i)
#pragma unroll
        for (int r = 0; r < 16; ++r) o[i][r] = 0.f;
    float mref = 0.f, lrun = 0.f;
    int tl = tid; asm volatile("" : "+v"(tl));
    AS_GLOAD(0); AS_LSTORE(); __syncthreads();
    const int grp = wid >> 2;
    for (int pi = 0; pi < (AS_NT + 1) / 2; ++pi) {
        const int j = 2 * pi + grp, buf = grp;
        asm volatile("" : "+v"(tl));
        if (2 * pi + 2 < AS_NT) AS_GLOAD(pi + 1);
        if (j < AS_NT) {
            f32x16 s0, s1;
            { const float negm = -mref;
#pragma unroll
              for (int r = 0; r < 16; ++r) { s0[r] = negm; s1[r] = negm; } }
            const LAS unsigned char* kb = lds + KV0 + buf * KB + (r32 * KP + 8 * hi) * 2;
#pragma unroll
            for (int g0 = 0; g0 < ND0; ++g0) {
                const bf16x8 ka = *(const LAS bf16x8*)(kb + g0 * 32), kc = *(const LAS bf16x8*)(kb + 32 * KP * 2 + g0 * 32), qq = *(const LAS bf16x8*)(qb_ + g0 * 32);
                s0 = MFMA32(ka, qq, s0); s1 = MFMA32(kc, qq, s1);
            }
            if (j == AS_NT - 1) {
#pragma unroll
                for (int r = 0; r < 16; ++r) { if (crow(r, hi) >= AS_NK - 64 * (AS_NT - 1)) s0[r] = -INFINITY; if (32 + crow(r, hi) >= AS_NK - 64 * (AS_NT - 1)) s1[r] = -INFINITY; }
            }
            float mx = fmaxf(fmaxf(s0[0], s1[0]), fmaxf(s0[1], s1[1]));
#pragma unroll
            for (int r = 2; r < 16; r += 2) mx = fmaxf(mx, fmaxf(fmaxf(s0[r], s1[r]), fmaxf(s0[r + 1], s1[r + 1])));
            { auto rr = __builtin_amdgcn_permlane32_swap(__float_as_uint(mx), __float_as_uint(mx), false, false); mx = fmaxf(__uint_as_float(rr[0]), __uint_as_float(rr[1])); }
            if (pi == 0 || __any(mx > 8.0f)) {
                const float dl = (pi == 0 || mx > 8.0f) ? mx : 0.f; mref += dl;
                const float al = __builtin_amdgcn_exp2f(-dl); lrun *= al;
#pragma unroll
                for (int r = 0; r < 16; ++r) { s0[r] -= dl; s1[r] -= dl; }
#pragma unroll
                for (int i = 0; i < NDB; ++i)
#pragma unroll
                    for (int r = 0; r < 16; ++r) o[i][r] *= al;
            }
            float ls = 0.f;
#pragma unroll
            for (int r = 0; r < 16; ++r) { s0[r] = __builtin_amdgcn_exp2f(s0[r]); s1[r] = __builtin_amdgcn_exp2f(s1[r]); ls += s0[r] + s1[r]; }
            lrun += ls;
            bf16x8 pf[4]; pf[0] = pack8(s0, 0); pf[1] = pack8(s0, 8); pf[2] = pack8(s1, 0); pf[3] = pack8(s1, 8);
            const LAS unsigned char* vb = lds + KV0 + 2 * KB + buf * VB + (r32 * VP + 4 * hi) * 2;
#pragma unroll
            for (int dp = 0; dp < NDB; ++dp) {
                u32x2 vl[4], vh[4];
#pragma unroll
                for (int q = 0; q < 4; ++q) { const LAS unsigned char* vp = vb + (dp * 32 * VP + 16 * q) * 2; vl[q] = *(const LAS u32x2*)vp; vh[q] = *(const LAS u32x2*)(vp + 16); }
#pragma unroll
                for (int q = 0; q < 4; ++q) { const u32x4 v4 = (u32x4){vl[q].x, vl[q].y, vh[q].x, vh[q].y}; o[dp] = MFMA32(__builtin_bit_cast(bf16x8, v4), pf[q], o[dp]); }
            }
        }
        __syncthreads();
        if (2 * pi + 2 < AS_NT) { AS_LSTORE(); }
        __syncthreads();
    }
#undef AS_GLOAD
#undef AS_LSTORE
    { LAS float* MG = (LAS float*)(lds + KV0) + ((wid & 3) * 64 + lane) * 67;
      if (grp == 1) { MG[0] = mref; MG[1] = lrun;
#pragma unroll
          for (int i = 0; i < NDB; ++i)
#pragma unroll
              for (int r = 0; r < 16; ++r) MG[2 + i * 16 + r] = o[i][r]; }
      __syncthreads();
      if (grp == 0) { const float m1 = MG[0], l1 = MG[1], mm = fmaxf(mref, m1), f0 = __builtin_amdgcn_exp2f(mref - mm), f1 = __builtin_amdgcn_exp2f(m1 - mm);
          lrun = lrun * f0 + l1 * f1;
#pragma unroll
          for (int i = 0; i < NDB; ++i)
#pragma unroll
              for (int r = 0; r < 16; ++r) o[i][r] = o[i][r] * f0 + MG[2 + i * 16 + r] * f1; }
      __syncthreads(); }
    if (wid < 4) { const float lt = half_sum(lrun), inv = 1.f / lt; bf16* OLAT = WSB(ws_olat);
        bf16* orow = OLAT + (size_t)(b * 128 + wid * 32 + r32) * 128 + 4 * hi;
#pragma unroll
        for (int db = 0; db < NDB; ++db)
#pragma unroll
            for (int rg = 0; rg < 4; ++rg) { u32x2 w; w.x = pk2(o[db][4 * rg] * inv, o[db][4 * rg + 1] * inv); w.y = pk2(o[db][4 * rg + 2] * inv, o[db][4 * rg + 3] * inv);
                *(u32x2*)(orow + 32 * db + 8 * rg) = w; } }
    __threadfence(); __syncthreads();
    { LAS float* OLT = (LAS float*)(lds + KV0);
      const bf16* OLAT = WSB(ws_olat); const float* w_uv = INP(15); bf16* MIXED = WSB(ws_mixed);
#pragma unroll
      for (int i = 0; i < 4; ++i) { const int idx = tid + 512 * i, row = idx >> 4, c8 = idx & 15; const u32x4 v = *(const u32x4*)(OLAT + (size_t)(b * 128 + row) * 128 + 8 * c8);
          LAS float* d = OLT + ((row >> 4) * 128 + 8 * c8) * 16 + (row & 15);
#pragma unroll
          for (int e = 0; e < 4; ++e) { d[(2 * e) * 16] = bflo(v[e]); d[(2 * e + 1) * 16] = bfhi(v[e]); } }
      __syncthreads();
      const int d = tid & 63, h = tid >> 6; float acc[16];
#pragma unroll
      for (int t = 0; t < 16; ++t) acc[t] = 0.f;
#pragma unroll 8
      for (int r = 0; r < 128; ++r) { const float w = w_uv[(size_t)(r * 8 + h) * 64 + d]; const LAS float* ol = OLT + (h * 128 + r) * 16;
#pragma unroll
          for (int t4 = 0; t4 < 4; ++t4) { const f32x4 x = *(const LAS f32x4*)(ol + 4 * t4); acc[4 * t4] += x.x * w; acc[4 * t4 + 1] += x.y * w; acc[4 * t4 + 2] += x.z * w; acc[4 * t4 + 3] += x.w * w; } }
#pragma unroll
      for (int t = 0; t < 16; ++t) MIXED[(size_t)(rowbase + t) * 1024 + h * 64 + d] = f2bf(acc[t]); }
    __syncthreads();
}
__device__ __forceinline__ void cross_sample_item(LAS unsigned char* lds, const bf16* QC, const float* mk, const float* mv, bf16* OC, int b, int hh) {
    LAS float* qc = (LAS float*)lds;
    LAS float* Pw = qc + 16 * 256;
    LAS float* KT = Pw + 8 * 512;
    const int tid_ = my_tid(lds); const int tid = tid_, lane = tid & 63; const int wid = __builtin_amdgcn_readfirstlane(tid >> 6);
    const int rowbase = MP + b * 16;
#pragma unroll
    for (int i = 0; i < 8; ++i) { const int idx = tid + 512 * i, t = idx >> 8, e = idx & 255; qc[idx] = bf2f(QC[(size_t)(rowbase + t) * 1024 + hh * 256 + e]); }
    const int t0 = 2 * wid; const LAS float* q0 = qc + t0 * 256; const LAS float* q1 = q0 + 256; LAS float* P = Pw + wid * 512;
    float s0[4], s1[4];
#pragma unroll 1
    for (int jt = 0; jt < 4; ++jt) {
        f32x4 st[8];
#pragma unroll
        for (int i = 0; i < 8; ++i) { const int ci = tid + 512 * i, key = ci >> 6, ch = ci & 63; st[i] = *(const f32x4*)(mk + ((size_t)(b * 256 + 64 * jt + key) * 4 + hh) * 256 + 4 * ch); }
        __syncthreads();
#pragma unroll
        for (int i = 0; i < 8; ++i) { const int ci = tid + 512 * i, key = ci >> 6, ch = ci & 63; *(LAS f32x4*)(KT + key * 260 + 4 * ch) = st[i]; }
        __syncthreads();
        const LAS float* kr = KT + lane * 260; float a0 = 0.f, a1 = 0.f;
#pragma unroll 8
        for (int i = 0; i < 64; ++i) { const f32x4 kv = *(const LAS f32x4*)(kr + 4 * i); const f32x4 a = *(const LAS f32x4*)(q0 + 4 * i), c = *(const LAS f32x4*)(q1 + 4 * i);
            a0 += (kv.x * a.x + kv.y * a.y) + (kv.z * a.z + kv.w * a.w); a1 += (kv.x * c.x + kv.y * c.y) + (kv.z * c.z + kv.w * c.w); }
        if (jt == 0) { s0[0] = a0; s1[0] = a1; } else if (jt == 1) { s0[1] = a0; s1[1] = a1; } else if (jt == 2) { s0[2] = a0; s1[2] = a1; } else { s0[3] = a0; s1[3] = a1; }
    }
    const float mx0 = wave_max(fmaxf(fmaxf(s0[0], s0[1]), fmaxf(s0[2], s0[3]))), mx1 = wave_max(fmaxf(fmaxf(s1[0], s1[1]), fmaxf(s1[2], s1[3])));
    float sm0 = 0.f, sm1 = 0.f;
#pragma unroll
    for (int j = 0; j < 4; ++j) { const float p0 = __builtin_amdgcn_exp2f(s0[j] - mx0), p1 = __builtin_amdgcn_exp2f(s1[j] - mx1); P[lane + 64 * j] = p0; P[256 + lane + 64 * j] = p1; sm0 += p0; sm1 += p1; }
    sm0 = wave_sum(sm0); sm1 = wave_sum(sm1);
    asm volatile("s_waitcnt lgkmcnt(0)" ::: "memory");
    f32x4 o0 = {0.f, 0.f, 0.f, 0.f}, o1 = {0.f, 0.f, 0.f, 0.f};
    const float* vbp = mv + ((size_t)(b * 256) * 4 + hh) * 256 + 4 * lane;
#pragma unroll 1
    for (int m0 = 0; m0 < 256; m0 += 16) { f32x4 vv[16];
#pragma unroll
        for (int i = 0; i < 16; ++i) vv[i] = *(const f32x4*)(vbp + (size_t)(m0 + i) * 1024);
#pragma unroll
        for (int i = 0; i < 16; ++i) { o0 += vv[i] * P[m0 + i]; o1 += vv[i] * P[256 + m0 + i]; } }
    const float i0 = 1.f / sm0, i1 = 1.f / sm1; o0 = o0 * i0; o1 = o1 * i1;
    u32x2 w0, w1; w0.x = pk2(o0.x, o0.y); w0.y = pk2(o0.z, o0.w); w1.x = pk2(o1.x, o1.y); w1.y = pk2(o1.z, o1.w);
    *(u32x2*)(OC + (size_t)(rowbase + t0) * 1024 + hh * 256 + 4 * lane) = w0; *(u32x2*)(OC + (size_t)(rowbase + t0 + 1) * 1024 + hh * 256 + 4 * lane) = w1;
    __syncthreads();
}
__device__ __forceinline__ void conv_act_item(LAS unsigned char* lds, const bf16* U, int grow0, int blk, const float* cw, const float* cb, const float* sbuf, bf16* ACT) {
    const int tid_ = my_tid(lds); const int tid = tid_; if (tid >= 352) return;
    const int f0 = 8 * tid, R0 = grow0 + 16 * blk, ac = 256 * (f0 >> 7) + (f0 & 127), gc = ac + 128;
    float w0a[8], w1a[8], w2a[8], ba[8], w0g[8], w1g[8], w2g[8], bg[8], a2[8], a1[8], g2[8], g1[8];
#pragma unroll
    for (int i = 0; i < 8; ++i) { w0a[i] = cw[f0 + i]; w1a[i] = cw[NUP + f0 + i]; w2a[i] = cw[2 * NUP + f0 + i]; ba[i] = cb[f0 + i];
        w0g[i] = cw[NFF + f0 + i]; w1g[i] = cw[NUP + NFF + f0 + i]; w2g[i] = cw[2 * NUP + NFF + f0 + i]; bg[i] = cb[NFF + f0 + i]; }
    if (R0 >= MP) { const float* sb = sbuf + (size_t)((R0 - MP) >> 4) * 2 * NUP;
#pragma unroll
        for (int i = 0; i < 8; ++i) { a2[i] = sb[f0 + i]; a1[i] = sb[NUP + f0 + i]; g2[i] = sb[NFF + f0 + i]; g1[i] = sb[NUP + NFF + f0 + i]; }
    } else if ((R0 & (SEQ - 1)) == 0) {
#pragma unroll
        for (int i = 0; i < 8; ++i) { a2[i] = 0.f; a1[i] = 0.f; g2[i] = 0.f; g1[i] = 0.f; }
    } else { const bf16* u2 = U + (size_t)(R0 - 2 - grow0) * NUP; const bf16* u1 = u2 + NUP;
        const u32x4 x2 = *(const u32x4*)(u2 + ac), y2 = *(const u32x4*)(u2 + gc), x1 = *(const u32x4*)(u1 + ac), y1 = *(const u32x4*)(u1 + gc);
#pragma unroll
        for (int e = 0; e < 4; ++e) { a2[2 * e] = bflo(x2[e]); a2[2 * e + 1] = bfhi(x2[e]); g2[2 * e] = bflo(y2[e]); g2[2 * e + 1] = bfhi(y2[e]);
            a1[2 * e] = bflo(x1[e]); a1[2 * e + 1] = bfhi(x1[e]); g1[2 * e] = bflo(y1[e]); g1[2 * e + 1] = bfhi(y1[e]); } }
    for (int t = 0; t < 16; ++t) { const bf16* u0 = U + (size_t)(R0 + t - grow0) * NUP; const u32x4 x0 = *(const u32x4*)(u0 + ac), y0 = *(const u32x4*)(u0 + gc);
        float a0[8], g0[8], r[8];
#pragma unroll
        for (int e = 0; e < 4; ++e) { a0[2 * e] = bflo(x0[e]); a0[2 * e + 1] = bfhi(x0[e]); g0[2 * e] = bflo(y0[e]); g0[2 * e + 1] = bfhi(y0[e]); }
#pragma unroll
        for (int i = 0; i < 8; ++i) { const float ca = ba[i] + w0a[i] * a2[i] + w1a[i] * a1[i] + w2a[i] * a0[i], cg = bg[i] + w0g[i] * g2[i] + w1g[i] * g1[i] + w2g[i] * g0[i];
            r[i] = silu(ca) * cg; a2[i] = a1[i]; a1[i] = a0[i]; g2[i] = g1[i]; g1[i] = g0[i]; }
        u32x4 w; w.x = pk2(r[0], r[1]); w.y = pk2(r[2], r[3]); w.z = pk2(r[4], r[5]); w.w = pk2(r[6], r[7]);
        *(u32x4*)(ACT + (size_t)(R0 + t) * NFF + f0) = w; }
}

__device__ __forceinline__ void conv_fix_item(LAS unsigned char* lds, const bf16* HB, int gi, const float* cw, const float* cb, bf16* ACT) {
    const int tid = my_tid(lds); if (tid >= 352) return;
    const int f0 = 8 * tid; const bool first = (gi & 255) == 0;
    const bf16* h = HB + (size_t)gi * 4 * NUP; const bf16* hp = HB + (size_t)(gi - 1) * 4 * NUP;
    float r0[8], r1[8];
#pragma unroll
    for (int part = 0; part < 2; ++part) { const int c0 = part * NFF + f0;
        const u32x4 u0 = *(const u32x4*)(h + c0), u1 = *(const u32x4*)(h + NUP + c0);
        u32x4 p2 = {0u, 0u, 0u, 0u}, p3 = {0u, 0u, 0u, 0u}; if (!first) { p2 = *(const u32x4*)(hp + 2 * NUP + c0); p3 = *(const u32x4*)(hp + 3 * NUP + c0); }
#pragma unroll
        for (int i = 0; i < 8; ++i) { const float w0 = cw[c0 + i], w1 = cw[NUP + c0 + i], w2 = cw[2 * NUP + c0 + i], bb = cb[c0 + i];
            const float x0 = (i & 1) ? bfhi(u0[i >> 1]) : bflo(u0[i >> 1]), x1 = (i & 1) ? bfhi(u1[i >> 1]) : bflo(u1[i >> 1]);
            const float q2 = (i & 1) ? bfhi(p2[i >> 1]) : bflo(p2[i >> 1]), q3 = (i & 1) ? bfhi(p3[i >> 1]) : bflo(p3[i >> 1]);
            const float c_0 = bb + w0 * q2 + w1 * q3 + w2 * x0, c_1 = bb + w0 * q3 + w1 * x0 + w2 * x1;
            if (part == 0) { r0[i] = silu(c_0); r1[i] = silu(c_1); } else { r0[i] *= c_0; r1[i] *= c_1; } } }
    u32x4 w; w.x = pk2(r0[0], r0[1]); w.y = pk2(r0[2], r0[3]); w.z = pk2(r0[4], r0[5]); w.w = pk2(r0[6], r0[7]); *(u32x4*)(ACT + (size_t)(64 * gi) * NFF + f0) = w;
    w.x = pk2(r1[0], r1[1]); w.y = pk2(r1[2], r1[3]); w.z = pk2(r1[4], r1[5]); w.w = pk2(r1[6], r1[7]); *(u32x4*)(ACT + (size_t)(64 * gi + 1) * NFF + f0) = w;
}
constexpr size_t MiB = 1u << 20;
constexpr size_t WS_CTL = 0;
constexpr size_t WS_WIN = 1 * MiB, WS_WUQ = 6 * MiB, WS_WUK = 6 * MiB + 512 * 1024, WS_WUV = 6 * MiB + 768 * 1024, WS_WO = 7 * MiB, WS_WCQ = 9 * MiB, WS_WCKV = 11 * MiB, WS_WCO = 15 * MiB,
                 WS_WUP = 17 * MiB, WS_WDN = 28 * MiB, WS_MN = 34 * MiB, WS_MK = 35 * MiB, WS_MVT = 36 * MiB;
constexpr size_t WS_H = 38 * MiB;
constexpr size_t WS_CQN = WS_H, WS_CKV = WS_H + 17 * MiB, WS_MIXED = WS_H;
constexpr size_t WS_Z = 104 * MiB;
constexpr size_t WS_KR = 267 * MiB, WS_Q = 269 * MiB, WS_KN = 318 * MiB, WS_VT = 350 * MiB, WS_AT = 382 * MiB, WS_END = 510 * MiB;
constexpr size_t WS_QC = 104 * MiB, WS_OC = 170 * MiB;
constexpr size_t WS_U = 104 * MiB, WS_HB = 104 * MiB, WS_US = 136 * MiB, WS_OCS = 286 * MiB, WS_QA = 287 * MiB, WS_OLAT = 288 * MiB + 512 * 1024, WS_ACT = 290 * MiB;
static_assert(WS_WUP + (size_t)NUP * 1024 * 2 <= WS_WDN && WS_WDN + (size_t)1024 * NFF * 2 <= WS_MN && WS_H + (size_t)MT * 1024 * 2 <= WS_Z && WS_Z + (size_t)MT * NZ * 2 <= WS_KR &&
              WS_Q + (size_t)MT * 768 * 2 <= WS_KN && WS_AT + (size_t)2 * 256 * 4 * 16384 * 4 <= WS_END && WS_U + (size_t)(16384 + 512) * NUP * 2 <= WS_ACT && WS_ACT + (size_t)MT * NFF * 2 <= WS_END &&
              WS_CQN + (size_t)MT * 256 * 2 <= WS_CKV && WS_OC + (size_t)MT * 1024 * 2 <= WS_KR, "ws map");
constexpr int LDS_BYTES = 155648;
#ifndef SUB
#define SUB 15
#endif
#ifndef PH
#define PH 0xfff
#endif


#define RLX_AGENT __ATOMIC_RELAXED, __HIP_MEMORY_SCOPE_AGENT
#define XB_TMO      128
#define XB_XCNT(j)  (256  + 64 * (j))
#define XB_XSUB(j)  (1280 + 64 * (j))
#define XB_XGEN(j)  (2304 + 64 * (j))
#define XB_TOP      3328
#define XB_TOPGEN   3392
#define XCD_BAR_WORDS 3456
#define XB_SPIN_CAP (1u << 22)
__device__ __forceinline__ unsigned xb_ld(unsigned* p)              { return __hip_atomic_load(p, __ATOMIC_RELAXED, __HIP_MEMORY_SCOPE_AGENT); }
__device__ __forceinline__ unsigned xb_add(unsigned* p, unsigned v) { return __hip_atomic_fetch_add(p, v, __ATOMIC_RELAXED, __HIP_MEMORY_SCOPE_AGENT); }
__device__ __forceinline__ unsigned xb_xcc_id() { return (unsigned)__builtin_amdgcn_s_getreg((3 << 11) | 20) & 0xFu; }
#define XB_SPIN(cond, bar) do { unsigned _sp = 0; while (cond) { __builtin_amdgcn_s_sleep(1); \
    if ((++_sp & 255u) == 0u) { if (xb_ld(&(bar)[XB_TMO])) break; if (_sp > XB_SPIN_CAP) { atomicAdd(&(bar)[XB_TMO], 1u); break; } } } } while (0)
struct XcdBarrier { unsigned* bar; unsigned x; volatile LAS unsigned* st; };
__device__ __forceinline__ XcdBarrier xcd_barrier_post(unsigned* bar, volatile LAS unsigned* st) {
    XcdBarrier b; b.bar = bar; b.x = xb_xcc_id(); b.st = st;
    if (threadIdx.x == 0) (void)xb_add(&bar[XB_XCNT(b.x)], 1u);
    return b;
}
__device__ __forceinline__ void xcd_barrier_complete(unsigned* bar, unsigned x, unsigned& nloc, unsigned& nx) {
    const unsigned G = gridDim.x * gridDim.y * gridDim.z;
    unsigned sum, cnt, mine, sp = 0u;
    for (;;) {
        sum = 0u; cnt = 0u; mine = 0u;
#pragma unroll
        for (unsigned j = 0; j < 16; ++j) { const unsigned c = xb_ld(&bar[XB_XCNT(j)]); sum += c; cnt += (c > 0u) ? 1u : 0u; mine = (j == x) ? c : mine; }
        if (sum == G) break;
        __builtin_amdgcn_s_sleep(1);
        if ((++sp & 255u) == 0u) { if (xb_ld(&bar[XB_TMO])) break; if (sp > XB_SPIN_CAP) { atomicAdd(&bar[XB_TMO], 1u); break; } }
    }
    nloc = mine > 0u ? mine : 1u; nx = cnt > 0u ? cnt : 1u;
}
__device__ __forceinline__ void xcd_barrier(const XcdBarrier& b, bool leader) {
    asm volatile("s_waitcnt vmcnt(0)" ::: "memory");
    __syncthreads();
    if (leader) {
        unsigned* bar = b.bar;
        __builtin_amdgcn_s_waitcnt(0);
        unsigned nloc = b.st[0], nx = b.st[1];
        if (nloc == 0u) { xcd_barrier_complete(bar, b.x, nloc, nx); b.st[0] = nloc; b.st[1] = nx; }
        const unsigned old = xb_add(&bar[XB_XSUB(b.x)], 1u);
        const unsigned gen = old / nloc;
        if (old + 1u == (gen + 1u) * nloc) {
            __builtin_amdgcn_fence(__ATOMIC_RELEASE, "agent");
            asm volatile("s_waitcnt vmcnt(0)" ::: "memory");
            const unsigned og = xb_add(&bar[XB_TOP], 1u);
            const unsigned tg = og / nx;
            if (og + 1u == (tg + 1u) * nx) xb_add(&bar[XB_TOPGEN], 1u);
            else XB_SPIN(xb_ld(&bar[XB_TOPGEN]) == tg, bar);
            __builtin_amdgcn_fence(__ATOMIC_ACQUIRE, "agent");
            xb_add(&bar[XB_XGEN(b.x)], 1u);
            asm volatile("s_waitcnt vmcnt(0)" ::: "memory");
        } else {
            XB_SPIN(xb_ld(&bar[XB_XGEN(b.x)]) == gen, bar);
            __builtin_amdgcn_fence(__ATOMIC_ACQUIRE, "agent");
            asm volatile("s_waitcnt vmcnt(0)" ::: "memory");
        }
    }
    __syncthreads();
}
constexpr size_t CTL_ZERO_BYTES = 65536;

struct Params { const float* in[30]; float* out; unsigned char* ws; };

#define GSYNC() do { XcdBarrier xb_; xb_.bar = (unsigned*)tab_get(lds, 31) + 1024; xb_.x = xb_xcc_id(); xb_.st = (volatile LAS unsigned*)(lds + TAB_OFF + 256); xcd_barrier(xb_, my_tid(lds) == 0); } while (0)
#define fresh_lane() (my_tid(lds) & 63)
#define LGS(a) float a[4]; _Pragma("unroll") for (int i_ = 0; i_ < 4; ++i_) a[i_] = log2f(1.0f - exp2f(-5.0f - (float)i_))

__global__ void __launch_bounds__(512, 2) mega_fwd(Params p) {
    extern __shared__ __attribute__((aligned(16))) unsigned char lds_raw[];
    LAS unsigned char* lds = (LAS unsigned char*)lds_raw;
    cg::grid_group grid = cg::this_grid();
    const int tid = threadIdx.x; const int wave = __builtin_amdgcn_readfirstlane(tid >> 6);
    const int G = gridDim.x, bx = blockIdx.x; const int vcu = (G % 8 == 0) ? (bx % 8) * (G / 8) + bx / 8 : bx;
    const int gw = vcu * 8 + wave, NGW = G * 8;
    { const unsigned hw = (unsigned)__builtin_amdgcn_s_getreg((5 << 11) | 4) & 63u; *(volatile LAS int*)(lds + TAB_OFF + 512 + 4 * hw) = tid >> 6; }
    if (tid == 0) { LAS unsigned long long* tab = (LAS unsigned long long*)(lds + TAB_OFF);
#pragma unroll
        for (int i = 0; i < 30; ++i) tab[i] = (unsigned long long)p.in[i];
        tab[30] = (unsigned long long)p.out; tab[31] = (unsigned long long)p.ws;
        ((volatile LAS unsigned*)(lds + TAB_OFF + 256))[0] = 0u; ((volatile LAS unsigned*)(lds + TAB_OFF + 256))[1] = 0u; }
    __syncthreads();
    (void)xcd_barrier_post((unsigned*)p.ws + 1024, (volatile LAS unsigned*)(lds + TAB_OFF + 256));

#define QNEXT(ctrw, dst) do { __syncthreads(); if (my_tid(lds) == 0) *(volatile LAS int*)(lds + TAB_OFF + 264) = (int)atomicAdd((unsigned*)tab_get(lds, 31) + 8192 + 64 * (ctrw), 1u); \
        __syncthreads(); dst = __builtin_amdgcn_readfirstlane(*(volatile LAS int*)(lds + TAB_OFF + 264)); } while (0)
#define SROWS (size_t)MP
    {
        const int lane = fresh_lane(); LAS float* scr = (LAS float*)(lds + wave * 16384);
        constexpr int I_IN = 16 * 77, I_UQ = 4 * 24, I_UK = 2 * 16, I_UV = 2 * 16, I_SQ = 16 * 32, I_UP = 16 * 176, I_DN = 44 * 32;
        constexpr int NITEMS = I_IN + I_UQ + I_UK + I_UV + 5 * I_SQ + I_UP + I_DN;
        for (int it = gw; it < NITEMS; it += NGW) {
            int r = it;
            if (r < I_IN) { p0_transpose_item(INP(10), 1024, ZC_END, WSB(WS_WIN), 1.f, 0, scr, r, lane); continue; } r -= I_IN;
            if (r < I_UQ) { p0_transpose_item(INP(13), 256, 768, WSB(WS_WUQ), 0.10206207261596577f * LOG2E, 0, scr, r, lane); continue; } r -= I_UQ;
            if (r < I_UK) { p0_transpose_item(INP(14), 128, 512, WSB(WS_WUK), 1.f, 0, scr, r, lane); continue; } r -= I_UK;
            if (r < I_UV) { p0_transpose_item(INP(15), 128, 512, WSB(WS_WUV), 1.f, 0, scr, r, lane); continue; } r -= I_UV;
            if (r < I_SQ) { p0_transpose_item(INP(17), 1024, 1024, WSB(WS_WO), 1.f, 0, scr, r, lane); continue; } r -= I_SQ;
            if (r < I_SQ) { p0_transpose_item(INP(20), 1024, 1024, WSB(WS_WCQ), 0.0625f * LOG2E, 0, scr, r, lane); continue; } r -= I_SQ;
            if (r < I_SQ) { p0_transpose_item(INP(21), 1024, 1024, WSB(WS_WCKV), 1.f, 0, scr, r, lane); continue; } r -= I_SQ;
            if (r < I_SQ) { p0_transpose_item(INP(22), 1024, 1024, WSB(WS_WCKV), 1.f, 1024, scr, r, lane); continue; } r -= I_SQ;
            if (r < I_SQ) { p0_transpose_item(INP(23), 1024, 1024, WSB(WS_WCO), 1.f, 0, scr, r, lane); continue; } r -= I_SQ;
            if (r < I_UP) { p0_transpose_item(INP(25), 1024, NUP, WSB(WS_WUP), 1.f, 0, scr, r, lane, 1); continue; } r -= I_UP;
            p0_transpose_item(INP(28), NFF, 1024, WSB(WS_WDN), 1.f, 0, scr, r, lane);
        }
        { const int t_ = my_tid(lds); bf16* WIN = WSB(WS_WIN); for (int i = bx * 512 + t_; i < 96 * 128; i += G * 512) ((u32x4*)(WIN + (size_t)ZC_END * 1024))[i] = (u32x4){0u, 0u, 0u, 0u}; }
        { const float* x_p = INP(0); const float* x_s = INP(1); const float* g = INP(9); bf16* H = WSB(WS_H);
          for (int m = gw; m < MP; m += 2 * NGW) { const int m1 = m + NGW;
              if (m1 < MP) rms_row2_to_bf16(x_p + (size_t)m * DM, x_p + (size_t)m1 * DM, g, H + (size_t)m * DM, H + (size_t)m1 * DM, lane); else rms_row_to_bf16(x_p + (size_t)m * DM, g, H + (size_t)m * DM, lane); }
          for (int m = gw; m < MS; m += NGW) rms_row_to_bf16(x_s + (size_t)m * DM, g, H + (size_t)(MP + m) * DM, lane); }
        { const float* mem_p = INP(8); const float* g = INP(19); bf16* MN = WSB(WS_MN);
          for (int m = gw; m < 512; m += NGW) rms_row_to_bf16(mem_p + (size_t)m * DM, g, MN + (size_t)m * DM, lane); }
    }
    if (gridDim.y > 1u) grid.sync();
    GSYNC();
    { pg8::Gemm g{WSB(WS_H), WSB(WS_WIN), MP, NZ, 1024, 1024, 1024}; pg8::StaticOrder S; S.init(MP, NZ, G, bx); pg8::EpiStoreBf16 E{WSB(WS_Z), NZ}; pg8::gemm_phase(lds, g, S, E); }
    GSYNC();
    {
        { pg8::Gemm g{WSB(WS_H) + SROWS * DM, WSB(WS_WIN), MS, NZ, 1024, 1024, 1024}; pg8::StaticOrder S; S.init(MS, NZ, G, bx); pg8::EpiStoreBf16 E{WSB(WS_Z) + SROWS * NZ, NZ}; pg8::gemm_phase(lds, g, S, E); }
        { pg8::Gemm g{WSB(WS_MN), WSB(WS_WCKV), 512, 2048, 1024, 1024, 1024}; pg8::StaticOrder S; S.init(512, 2048, G, (bx + G - 20) % G); pg8::EpiMemKV E{OUTP(), WSB(WS_MK)}; pg8::gemm_phase(lds, g, S, E); }
        { pg8::Gemm g{WSB(WS_WCKV) + (size_t)1024 * 1024, WSB(WS_MN), 1024, 512, 1024, 1024, 1024}; pg8::StaticOrder S; S.init(1024, 512, G, (bx + G - 36) % G); pg8::EpiStoreBf16 E{WSB(WS_MVT), 512}; pg8::gemm_phase(lds, g, S, E); }
        { const int lane = fresh_lane(); bf16 *Z = WSB(WS_Z), *CQN = WSB(WS_CQN), *CKV = WSB(WS_CKV), *KR = WSB(WS_KR); float* out = OUTP(); const float *qg = INP(11), *kvg = INP(12);
          for (;;) { int it; QNEXT(0, it); if (it >= MP / 64) break;
#pragma unroll 1
              for (int k = 0; k < 8; ++k) row_post(Z, CQN, CKV, KR, out, qg, kvg, it * 64 + wave * 8 + k, lane); } }
    }
    GSYNC();
    {
        { const int lane = fresh_lane(); bf16 *Z = WSB(WS_Z), *CQN = WSB(WS_CQN), *CKV = WSB(WS_CKV), *KR = WSB(WS_KR); float* out = OUTP(); const float *qg = INP(11), *kvg = INP(12);
          for (int m = gw; m < MS; m += NGW) row_post(Z, CQN, CKV, KR, out, qg, kvg, MP + m, lane); }
        { pg8::Gemm g{WSB(WS_CQN), WSB(WS_WUQ), MP, 768, 256, 256, 256}; pg8::StaticOrder S; S.init(MP, 768, G, bx); pg8::EpiStoreBf16 E{WSB(WS_Q), 768}; pg8::gemm_phase(lds, g, S, E); }
        { pg8::Gemm g{WSB(WS_CKV), WSB(WS_WUK), MP, 512, 128, 128, 128}; pg8::StaticOrder S; S.init(MP, 512, G, (bx + 128) % G); pg8::EpiStoreBf16 E{WSB(WS_KN), 512}; pg8::gemm_phase(lds, g, S, E); }
        { pg8::Gemm g{WSB(WS_WUV), WSB(WS_CKV), 512, MP, 128, 128, 128}; pg8::StaticOrder S; S.init(512, MP, G, (bx + 128) % G); pg8::EpiStoreBf16 E{WSB(WS_VT), MP}; pg8::gemm_phase(lds, g, S, E); }
        { LGS(lgs); const bf16* Z = WSB(WS_Z); bf16* AT = WSB(WS_AT);
          for (int it = vcu; it < 2 * 256 * 4; it += G) { const int hh = it & 3, c = (it >> 2) & 255, b = it >> 10; ret_kv_item(lds, Z, AT, b, c, hh, lgs[hh]); } }
    }
    GSYNC();
    {
        { pg8::Gemm g{WSB(WS_CQN) + SROWS * 256, WSB(WS_WUQ), MS, 768, 256, 256, 256}; pg8::StaticOrder S; S.init(MS, 768, G, bx); pg8::EpiStoreBf16 E{WSB(WS_Q) + SROWS * 768, 768}; pg8::gemm_phase(lds, g, S, E); }
        { LGS(lgs); ret_scan(lds, WSB(WS_AT), OUTP(), G, lgs); }
        { const bf16 *Q = WSB(WS_Q), *KN = WSB(WS_KN), *KR = WSB(WS_KR), *VT = WSB(WS_VT); bf16* MIXED = WSB(WS_MIXED);
          for (int pr = vcu; pr < 512; pr += G) { const int bh = pr >> 5, pi = pr & 31, b = bh >> 3, h = bh & 7; const size_t rb = (size_t)b * SEQ;
#pragma unroll 1
            for (int k = 0; k < 2; ++k) { const int qb = k == 0 ? 63 - pi : pi;
                flash_unit<96, 64, 0>(lds, Q + (rb + 256 * qb) * 768 + h * 96, 768, KN + rb * 512 + h * 64, 512, KR + rb * 32, VT + (size_t)(h * 64) * MP + rb, MP,
                                      MIXED + (rb + 256 * qb) * 1024 + h * 64, 1024, 4 * qb + 4, 4 * qb, 256 * qb); } } }
    }
    GSYNC();
    {
        for (;;) { int it; QNEXT(5, it); if (it >= 32 + 512 + 128) break;
            if (it < 32) mla_sample_unit(lds, WS_Q, WS_OLAT, WS_MIXED, it);
            else if (it < 32 + 512) { LGS(lgs); const int i2 = it - 32; ret_out_item(lds, WSB(WS_Z), WSB(WS_AT), INP(16), WSB(WS_MIXED), i2 >> 8, i2 & 255, lgs); }
            else { LGS(lgs); const int i3 = it - 32 - 512, hh = i3 & 3; ret_sample_item(lds, WSB(WS_Z), INP(4), INP(16), OUTP(), WSB(WS_MIXED), i3 >> 2, hh, lgs[hh]); } }
    }
    GSYNC();
    { pg8::Gemm g{WSB(WS_MIXED), WSB(WS_WO), MP, 1024, 1024, 1024, 1024}; pg8::StaticOrder S; S.init(MP, 1024, G, bx); pg8::EpiResid E{INP(0), OUTP()}; pg8::gemm_phase(lds, g, S, E); }
    GSYNC();
    {
        { pg8::Gemm g{WSB(WS_MIXED) + SROWS * DM, WSB(WS_WO), MS, 1024, 1024, 1024, 1024}; pg8::StaticOrder S; S.init(MS, 1024, G, bx); pg8::EpiResid E{INP(1), OUTP() + SROWS * DM}; pg8::gemm_phase(lds, g, S, E); }
        { const int lane = fresh_lane(); const float* X = OUTP(); const float* g = INP(18); bf16* H = WSB(WS_H);
          for (;;) { int it; QNEXT(1, it); if (it >= MP / 64) break;
#pragma unroll 1
              for (int k = 0; k < 8; k += 2) { const int m = it * 64 + wave * 8 + k; rms_row2_to_bf16(X + (size_t)m * DM, X + (size_t)(m + 1) * DM, g, H + (size_t)m * DM, H + (size_t)(m + 1) * DM, lane); } } }
    }
    GSYNC();
    {
        { pg8::Gemm g{WSB(WS_H), WSB(WS_WCQ), MP, 1024, 1024, 1024, 1024}; pg8::StaticOrder S; S.init(MP, 1024, G, bx); pg8::EpiStoreBf16 E{WSB(WS_QC), 1024}; pg8::gemm_phase(lds, g, S, E); }
        { const int lane = fresh_lane(); const float* X = OUTP(); const float* g = INP(18); bf16* H = WSB(WS_H);
          for (int m = MP + gw; m < MT; m += NGW) rms_row_to_bf16(X + (size_t)m * DM, g, H + (size_t)m * DM, lane); }
    }
    GSYNC();
    {
        { pg8::Gemm g{WSB(WS_H) + SROWS * DM, WSB(WS_WCQ), MS, 1024, 1024, 1024, 1024}; pg8::StaticOrder S; S.init(MS, 1024, G, bx); pg8::EpiStoreBf16 E{WSB(WS_QC) + SROWS * DM, 1024}; pg8::gemm_phase(lds, g, S, E); }
        { const bf16 *QC = WSB(WS_QC), *MK = WSB(WS_MK), *MVT = WSB(WS_MVT); bf16* OC = WSB(WS_OC);
          for (;;) { int it; QNEXT(2, it); if (it >= 512) break;
              const int bh = it >> 6, qb = it & 63, b = bh >> 2, hh = bh & 3; const size_t rb = (size_t)b * SEQ + 256 * qb;
              flash_unit<256, 256, 1>(lds, QC + rb * 1024 + hh * 256, 1024, MK + (size_t)(b * 256) * 1024 + hh * 256, 1024, nullptr, MVT + (size_t)(hh * 256) * 512 + b * 256, 512,
                                      OC + rb * 1024 + hh * 256, 1024, 4, 1000, 0); } }
    }
    GSYNC();
    { float* X = OUTP(); pg8::Gemm g{WSB(WS_OC), WSB(WS_WCO), MP, 1024, 1024, 1024, 1024}; pg8::StaticOrder S; S.init(MP, 1024, G, bx); pg8::EpiResid E{X, X}; pg8::gemm_phase(lds, g, S, E); }
    GSYNC();
    {
        const int lane = fresh_lane(); const bf16* QC = WSB(WS_QC); bf16* OC = WSB(WS_OCS) - SROWS * DM; const float *c_mk = INP(6), *c_mv = INP(7); const float* X = OUTP(); const float* g = INP(24); bf16* H = WSB(WS_H);
        for (;;) { int it; QNEXT(3, it); if (it >= 128 + MP / 64) break;
            if (it < 128) cross_sample_item(lds, QC, c_mk, c_mv, OC, it >> 2, it & 3);
            else {
#pragma unroll 1
                for (int k = 0; k < 8; k += 2) { const int m = (it - 128) * 64 + wave * 8 + k; rms_row2_to_bf16(X + (size_t)m * DM, X + (size_t)(m + 1) * DM, g, H + (size_t)m * DM, H + (size_t)(m + 1) * DM, lane); } } }
    }
    GSYNC();
    { pg8::Gemm g{WSB(WS_H), WSB(WS_WUP), MP, NUP, 1024, 1024, 1024}; pg8::StaticOrder S; S.init(MP, NUP, G, bx); pg8::EpiUpConv E{WSB(WS_ACT), WSB(WS_HB), OUTP(), INP(26), INP(27), lds}; pg8::gemm_phase(lds, g, S, E); }
    GSYNC();
    {
#pragma unroll 1
        for (int pc = 0; pc < 4; ++pc) { pg8::Gemm g{WSB(WS_OCS) + 256 * pc, WSB(WS_WCO) + 256 * pc, MS, 1024, 256, 1024, 1024}; pg8::StaticOrder S; S.init(MS, 1024, G, (bx + G - 8 * pc) % G); pg8::EpiAtomicAdd E{OUTP() + SROWS * DM}; pg8::gemm_phase(lds, g, S, E); }
        { const bf16* HB = WSB(WS_HB); bf16* ACT = WSB(WS_ACT); const float *cw = INP(26), *cb = INP(27);
          for (;;) { int it; QNEXT(6, it); if (it >= MP / 64 / 4) break;
#pragma unroll 1
              for (int k = 0; k < 4; ++k) conv_fix_item(lds, HB, it * 4 + k, cw, cb, ACT); } }
    }
    GSYNC();
    {
        { const int lane = fresh_lane(); const float* X = OUTP(); const float* g = INP(24); bf16* H = WSB(WS_H);
          for (int m = MP + gw; m < MT; m += NGW) rms_row_to_bf16(X + (size_t)m * DM, g, H + (size_t)m * DM, lane); }
        { float* X = OUTP(); pg8::Gemm g{WSB(WS_ACT), WSB(WS_WDN), MP, 1024, NFF, NFF, NFF}; pg8::StaticOrder S; S.init(MP, 1024, G, bx); pg8::EpiResid E{X, X}; pg8::gemm_phase(lds, g, S, E); }
    }
    GSYNC();
    {
        { pg8::Gemm g{WSB(WS_H) + SROWS * DM, WSB(WS_WUP), MS, NUP, 1024, 1024, 1024}; pg8::StaticOrder S; S.init(MS, NUP, G, bx); pg8::EpiUpConvS E{WSB(WS_ACT) + SROWS * NFF, OUTP(), INP(26), INP(27), INP(5), lds}; pg8::gemm_phase(lds, g, S, E); }
        { const int lane = fresh_lane(); float* X = OUTP(); const float* g = INP(29);
          for (;;) { int it; QNEXT(4, it); if (it >= MP / 64) break;
#pragma unroll 1
              for (int k = 0; k < 8; ++k) rms_row_f32_inplace(X + (size_t)(it * 64 + wave * 8 + k) * DM, g, lane); } }
    }
    GSYNC();
    {
#pragma unroll 1
        for (int pc = 0; pc < 4; ++pc) { const int k0 = pc < 2 ? 768 * pc : 1536 + 640 * (pc - 2), kl = pc < 2 ? 768 : 640;
            pg8::Gemm g{WSB(WS_ACT) + SROWS * NFF + k0, WSB(WS_WDN) + k0, MS, 1024, kl, NFF, NFF}; pg8::StaticOrder S; S.init(MS, 1024, G, (bx + G - 8 * pc) % G); pg8::EpiAtomicAdd E{OUTP() + SROWS * DM}; pg8::gemm_phase(lds, g, S, E); }
    }
    GSYNC();
    { const int lane = fresh_lane(); float* X = OUTP(); const float* g = INP(29); for (int m = MP + gw; m < MT; m += NGW) rms_row_f32_inplace(X + (size_t)m * DM, g, lane); }
}

extern "C" void kernel_launch(void* const* d_in, const int* in_sizes, int n_in, void* d_out, int out_size, void* d_ws, size_t ws_size, hipStream_t stream) {
    static int grid = 0;
    if (grid == 0) {
        if (n_in != 30 || (size_t)out_size != O_END || ws_size < WS_END) { fprintf(stderr, "kernel_launch: unexpected problem (n_in %d, out %d, ws %zu)\n", n_in, out_size, ws_size); grid = -1; return; }
        int dev = 0, cus = 0, per_cu = 0;
        (void)hipGetDevice(&dev); (void)hipDeviceGetAttribute(&cus, hipDeviceAttributeMultiprocessorCount, dev);
        if (hipFuncSetAttribute((const void*)mega_fwd, hipFuncAttributeMaxDynamicSharedMemorySize, LDS_BYTES) != hipSuccess) { fprintf(stderr, "kernel_launch: hipFuncSetAttribute failed\n"); grid = -1; return; }
        if (hipOccupancyMaxActiveBlocksPerMultiprocessor(&per_cu, (const void*)mega_fwd, 512, LDS_BYTES) != hipSuccess || per_cu < 1) { fprintf(stderr, "kernel_launch: occupancy query says %d\n", per_cu); per_cu = 1; }
        (void)hipGetLastError();
        grid = cus;
    }
    if (grid < 0) return;
    if (hipMemsetAsync(d_ws, 0, CTL_ZERO_BYTES, stream) != hipSuccess) { fprintf(stderr, "kernel_launch: memset failed\n"); return; }
    Params p{};
    for (int i = 0; i < 30; ++i) p.in[i] = (const float*)d_in[i];
    p.out = (float*)d_out; p.ws = (unsigned char*)d_ws;
    void* args[] = {&p};
    hipError_t e = hipLaunchCooperativeKernel((const void*)mega_fwd, dim3(grid), dim3(512), args, LDS_BYTES, stream);
    if (e != hipSuccess) fprintf(stderr, "kernel_launch: cooperative launch failed: %s (grid %d)\n", hipGetErrorString(e), grid);
}
```
